# Optimizing an MI355X kernel written in HIP

```python
import math
import jax, jax.numpy as jnp
from jax import lax
import numpy as np

D_MODEL = 1024
BATCH = 32
SEQ = 2048
DEPTH = 1

N_DIFF_HEADS = 4
DIFF_HEAD_DIM = 64
DIFF_WIDTH = N_DIFF_HEADS * 2 * DIFF_HEAD_DIM
N_MLA_HEADS = 4
MLA_NOPE_DIM = 128
MLA_ROPE_DIM = 64
MLA_QK_DIM = MLA_NOPE_DIM + MLA_ROPE_DIM
MLA_V_DIM = 128
MLA_Q_RANK = 384
MLA_KV_RANK = 256
MLA_WIDTH = N_MLA_HEADS * MLA_V_DIM
MIX_WIDTH = DIFF_WIDTH + MLA_WIDTH
IN_WIDTH = 3 * DIFF_WIDTH + MLA_Q_RANK + MLA_KV_RANK + MLA_ROPE_DIM
IN_SPLITS = [DIFF_WIDTH, 2 * DIFF_WIDTH, 3 * DIFF_WIDTH,
             3 * DIFF_WIDTH + MLA_Q_RANK, 3 * DIFF_WIDTH + MLA_Q_RANK + MLA_KV_RANK]
D_FF = -(-8 * D_MODEL // (3 * 256)) * 256
N_MOD = 6
Q_BLOCK = 128
ROPE_THETA = 10000.0
EPS = 1e-6

kernel_name = "hybrid_diffattn_mla_adaln_block"


def rms_norm(x, g):
    xf = x.astype(jnp.float32)
    y = xf * lax.rsqrt(jnp.mean(xf * xf, axis=-1, keepdims=True) + EPS)
    return (y * g.astype(jnp.float32)).astype(x.dtype)


def apply_rope(x, cos, sin):
    half = x.shape[-1] // 2
    x1, x2 = x[..., :half], x[..., half:]
    return jnp.concatenate([x1 * cos - x2 * sin, x1 * sin + x2 * cos], axis=-1)


def _scores(q, k, start, end, scale):
    s = jnp.einsum('bqhd,bkhd->bhqk', q[:, start:end], k[:, :end],
                   preferred_element_type=jnp.float32)
    return s * scale


def diff_attention(q1, q2, k1, k2, v, lam, slopes):
    S = q1.shape[1]
    scale = DIFF_HEAD_DIM ** -0.5
    outs = []
    for start in range(0, S, Q_BLOCK):
        end = start + Q_BLOCK
        rel = jnp.arange(start, end)[:, None] - jnp.arange(end)[None, :]
        causal = rel >= 0
        alibi = -slopes[:, None, None] * rel.astype(jnp.float32)[None]
        s1 = jnp.where(causal, _scores(q1, k1, start, end, scale) + alibi, -jnp.inf)
        s2 = jnp.where(causal, _scores(q2, k2, start, end, scale) + alibi, -jnp.inf)
        p = jax.nn.softmax(s1, axis=-1) - lam * jax.nn.softmax(s2, axis=-1)
        outs.append(jnp.einsum('bhqk,bkhd->bqhd', p.astype(v.dtype), v[:, :end]))
    return jnp.concatenate(outs, axis=1)


def causal_attention(q, k, v, scale):
    S = q.shape[1]
    outs = []
    for start in range(0, S, Q_BLOCK):
        end = start + Q_BLOCK
        causal = (jnp.arange(start, end)[:, None] - jnp.arange(end)[None, :]) >= 0
        s = jnp.where(causal, _scores(q, k, start, end, scale), -jnp.inf)
        p = jax.nn.softmax(s, axis=-1)
        outs.append(jnp.einsum('bhqk,bkhd->bqhd', p.astype(v.dtype), v[:, :end]))
    return jnp.concatenate(outs, axis=1)


def hybrid_mixer(h, w_in, lq1, lk1, lq2, lk2, g_diff_out, g_q_lat, w_q_up,
                 g_kv_lat, w_kv_up, w_out, cos, sin, lambda_init):
    B, S, _ = h.shape
    proj = h @ w_in
    dq, dk, dv, q_lat, kv_lat, k_rope = jnp.split(proj, IN_SPLITS, axis=-1)

    dq = dq.reshape(B, S, N_DIFF_HEADS, 2, DIFF_HEAD_DIM)
    dk = dk.reshape(B, S, N_DIFF_HEADS, 2, DIFF_HEAD_DIM)
    dv = dv.reshape(B, S, N_DIFF_HEADS, 2 * DIFF_HEAD_DIM)
    lam = (jnp.exp(jnp.sum(lq1.astype(jnp.float32) * lk1.astype(jnp.float32)))
           - jnp.exp(jnp.sum(lq2.astype(jnp.float32) * lk2.astype(jnp.float32)))
           + lambda_init)
    slopes = 2.0 ** (-8.0 * jnp.arange(1, N_DIFF_HEADS + 1, dtype=jnp.float32) / N_DIFF_HEADS)
    o_diff = diff_attention(dq[..., 0, :], dq[..., 1, :], dk[..., 0, :], dk[..., 1, :],
                            dv, lam, slopes)
    o_diff = rms_norm(o_diff, g_diff_out) * (1.0 - lambda_init)

    q = (rms_norm(q_lat, g_q_lat) @ w_q_up).reshape(B, S, N_MLA_HEADS, MLA_QK_DIM)
    q_nope, q_pe = q[..., :MLA_NOPE_DIM], q[..., MLA_NOPE_DIM:]
    q_pe = apply_rope(q_pe, cos[:, None, :], sin[:, None, :])
    kv = (rms_norm(kv_lat, g_kv_lat) @ w_kv_up).reshape(B, S, N_MLA_HEADS, MLA_NOPE_DIM + MLA_V_DIM)
    k_nope, v = kv[..., :MLA_NOPE_DIM], kv[..., MLA_NOPE_DIM:]
    k_pe = apply_rope(k_rope, cos, sin)
    k_pe = jnp.broadcast_to(k_pe[:, :, None, :], (B, S, N_MLA_HEADS, MLA_ROPE_DIM))
    q_full = jnp.concatenate([q_nope, q_pe], axis=-1)
    k_full = jnp.concatenate([k_nope, k_pe], axis=-1)
    o_mla = causal_attention(q_full, k_full, v, MLA_QK_DIM ** -0.5)

    merged = jnp.concatenate([o_diff.reshape(B, S, DIFF_WIDTH),
                              o_mla.reshape(B, S, MLA_WIDTH)], axis=-1)
    return merged @ w_out


def swiglu(h, w_gate, w_up, w_down):
    return (jax.nn.silu(h @ w_gate) * (h @ w_up)) @ w_down


def setup_inputs(seed: int = 0) -> dict:
    key = jax.random.key(seed)
    ks = jax.random.split(key, 24)
    f32 = jnp.float32

    def w(k, fan_in, fan_out, mult=1.0):
        return jax.random.normal(k, (DEPTH, fan_in, fan_out), f32) * (fan_in ** -0.5) * mult

    def gain(k, n):
        return 1.0 + 0.1 * jax.random.normal(k, (DEPTH, n), f32)

    gate_offset = jnp.repeat(jnp.array([0.0, 0.0, 1.0, 0.0, 0.0, 1.0], f32), D_MODEL)
    return {
        "x": jax.random.normal(ks[0], (BATCH, SEQ, D_MODEL), f32),
        "c": jax.random.normal(ks[1], (BATCH, D_MODEL), f32),
        "w_ada": w(ks[2], D_MODEL, N_MOD * D_MODEL, 0.1),
        "b_ada": 0.02 * jax.random.normal(ks[3], (DEPTH, N_MOD * D_MODEL), f32) + gate_offset[None],
        "g_mix": gain(ks[4], D_MODEL),
        "w_in": w(ks[5], D_MODEL, IN_WIDTH),
        "lambda_q1": 0.1 * jax.random.normal(ks[6], (DEPTH, DIFF_HEAD_DIM), f32),
        "lambda_k1": 0.1 * jax.random.normal(ks[7], (DEPTH, DIFF_HEAD_DIM), f32),
        "lambda_q2": 0.1 * jax.random.normal(ks[8], (DEPTH, DIFF_HEAD_DIM), f32),
        "lambda_k2": 0.1 * jax.random.normal(ks[9], (DEPTH, DIFF_HEAD_DIM), f32),
        "g_diff_out": gain(ks[10], 2 * DIFF_HEAD_DIM),
        "g_q_lat": gain(ks[11], MLA_Q_RANK),
        "w_q_up": w(ks[12], MLA_Q_RANK, N_MLA_HEADS * MLA_QK_DIM),
        "g_kv_lat": gain(ks[13], MLA_KV_RANK),
        "w_kv_up": w(ks[14], MLA_KV_RANK, N_MLA_HEADS * (MLA_NOPE_DIM + MLA_V_DIM)),
        "w_out": w(ks[15], MIX_WIDTH, D_MODEL),
        "g_ffn": gain(ks[16], D_MODEL),
        "w_ffn_gate": w(ks[17], D_MODEL, D_FF),
        "w_ffn_up": w(ks[18], D_MODEL, D_FF),
        "w_ffn_down": w(ks[19], D_FF, D_MODEL),
        "g_final": 1.0 + 0.1 * jax.random.normal(ks[20], (D_MODEL,), f32),
    }


def reference(x, c, w_ada, b_ada, g_mix, w_in, lambda_q1, lambda_k1, lambda_q2, lambda_k2,
              g_diff_out, g_q_lat, w_q_up, g_kv_lat, w_kv_up, w_out, g_ffn,
              w_ffn_gate, w_ffn_up, w_ffn_down, g_final):
    S = x.shape[1]
    inv_freq = ROPE_THETA ** (-jnp.arange(0, MLA_ROPE_DIM, 2, dtype=jnp.float32) / MLA_ROPE_DIM)
    ang = jnp.arange(S, dtype=jnp.float32)[:, None] * inv_freq[None, :]
    cos = jnp.cos(ang).astype(x.dtype)
    sin = jnp.sin(ang).astype(x.dtype)
    c_act = jax.nn.silu(c)
    for l in range(DEPTH):
        lambda_init = 0.8 - 0.6 * math.exp(-0.3 * l)
        mod = c_act @ w_ada[l] + b_ada[l]
        sh_a, sc_a, g_a, sh_f, sc_f, g_f = jnp.split(mod[:, None, :], N_MOD, axis=-1)
        h = rms_norm(x, g_mix[l]) * (1.0 + sc_a) + sh_a
        x = x + g_a * hybrid_mixer(h, w_in[l], lambda_q1[l], lambda_k1[l], lambda_q2[l],
                                   lambda_k2[l], g_diff_out[l], g_q_lat[l], w_q_up[l],
                                   g_kv_lat[l], w_kv_up[l], w_out[l], cos, sin, lambda_init)
        h = rms_norm(x, g_ffn[l]) * (1.0 + sc_f) + sh_f
        x = x + g_f * swiglu(h, w_ffn_gate[l], w_ffn_up[l], w_ffn_down[l])
    return rms_norm(x, g_final)
```

```cpp
#include <hip/hip_runtime.h>
#include <hip/hip_cooperative_groups.h>
#include <cstdio>
#include <cstdint>
namespace cg = cooperative_groups;

#ifndef MK_NL
#define MK_NL 1
#endif

#define LAS __attribute__((address_space(3)))
typedef unsigned short bf16_t;
typedef short bf16x8 __attribute__((ext_vector_type(8)));
typedef short s16x4 __attribute__((ext_vector_type(4)));
typedef float f32x4 __attribute__((ext_vector_type(4)));
typedef float f32x16 __attribute__((ext_vector_type(16)));
typedef unsigned u32x4 __attribute__((ext_vector_type(4)));
typedef unsigned u32x2 __attribute__((ext_vector_type(2)));

constexpr int NB = 32, SEQ = 2048, DM = 1024, TOK = NB * SEQ;
constexpr int NPROJ = 2304;
constexpr int NQ = 768, NKV = 1024, NFF = 2816, NGU = 2 * NFF;
constexpr int KQ = 384, KKV = 256;
constexpr float EPS = 1e-6f, LOG2E = 1.4426950408889634f;
constexpr float QS_DIFF = 0.125f * LOG2E;
constexpr float QS_MLA = 0.07216878364870322f * LOG2E;
constexpr float LAMBDA_INIT = 0.2f;

constexpr size_t MiB = 1u << 20;
constexpr size_t WS_WIN = 1 * MiB, WS_WQ = 6 * MiB, WS_WKV = 7 * MiB, WS_WOUT = 8 * MiB, WS_WGU = 10 * MiB, WS_WDN = 21 * MiB;
constexpr size_t WS_MOD = 27 * MiB, WS_CS = 28 * MiB, WS_SS = 29 * MiB, WS_SS2 = 34 * MiB;
constexpr size_t WS_XN = 64 * MiB, WS_PROJ = 192 * MiB, WS_Q = 480 * MiB, WS_KV = 576 * MiB, WS_MRG = 704 * MiB, WS_ACT = 192 * MiB, WS_END = 832 * MiB;

constexpr int RING_BYTES = 131072, LDS_BYTES = 147456;

__device__ __forceinline__ unsigned cvt_pk_bf16(float lo, float hi) { unsigned r; asm volatile("v_cvt_pk_bf16_f32 %0, %1, %2" : "=v"(r) : "v"(lo), "v"(hi)); return r; }
__device__ __forceinline__ unsigned f2bf(float f) { unsigned u = __builtin_bit_cast(unsigned, f); return (u + 0x7fffu + ((u >> 16) & 1u)) >> 16; }
__device__ __forceinline__ unsigned pk2(float lo, float hi) { return f2bf(lo) | (f2bf(hi) << 16); }
__device__ __forceinline__ u32x4 pack8(const f32x4 v0, const f32x4 v1) { u32x4 w; w.x = cvt_pk_bf16(v0[0], v0[1]); w.y = cvt_pk_bf16(v0[2], v0[3]); w.z = cvt_pk_bf16(v1[0], v1[1]); w.w = cvt_pk_bf16(v1[2], v1[3]); return w; }
__device__ __forceinline__ float wave_sum(float v) {
#pragma unroll
    for (int o = 1; o < 64; o <<= 1) v += __shfl_xor(v, o);
    return v;
}

namespace pg8 {
constexpr int BM = 256, BK = 64, HALF = 128, HTB = HALF * BK * 2, STAGE_BYTES = 8 * HTB, NXCD = 8, WGM = 8;
__host__ __device__ __forceinline__ int lds_byte(int r, int c) { const int st = (r >> 4) * 2 + (c >> 5), rr = r & 15, cc = c & 31, ob = rr * 64 + cc * 2; return st * 1024 + (ob ^ (((ob >> 9) & 1) << 5)); }
__host__ __device__ __forceinline__ void stage_rc(int b, int& R, int& C) { const int st = b / 1024, sb = b % 1024, swz = sb ^ (((sb >> 9) & 1) << 5); R = (st >> 1) * 16 + swz / 64; C = (st & 1) * 32 + (swz % 64) / 2; }
__host__ __device__ __forceinline__ int perm32(int rho) { const int n = rho >> 4, i = rho & 15; return 8 * (i >> 2) + 4 * n + (i & 3); }

struct Unit { int pm, pn; };
struct Gemm { const bf16_t* A; const bf16_t* Bt; int M, N, K, lda; };

struct StaticOrder {
    int nM, nN, nwg, G, c;
    __device__ void init(int M, int N, int G_, int c_) { nM = M / BM; nN = N / BM; nwg = nM * nN; G = G_; c = c_; }
    __device__ bool next(int i, Unit& u) const {
        const long L = (long)i * G + c; if (L >= nwg) return false;
        int wgid = (int)L; { const int q = nwg / NXCD, r = nwg % NXCD, xcd = wgid % NXCD, off = wgid / NXCD; wgid = (xcd < r ? xcd * (q + 1) : r * (q + 1) + (xcd - r) * q) + off; }
        const int nig = WGM * nN, gid = wgid / nig, fm = gid * WGM, gsz = (nM - fm) < WGM ? (nM - fm) : WGM;
        u.pm = fm + ((wgid % nig) % gsz); u.pn = (wgid % nig) / gsz; return true;
    }
};

template <class Epi, bool ALIGN_EPI>
__device__ __forceinline__ void gemm_phase(LAS unsigned char* lds, const Gemm g, const StaticOrder& S, Epi& E) {
    const int tid = threadIdx.x, wid = __builtin_amdgcn_readfirstlane(tid >> 6), lane = tid & 63, wr = wid >> 2, wc = wid & 3, fr = lane & 15, fq = lane >> 4;
    const int K = g.K, nt = K / BK, lda = g.lda;
    unsigned voffA[2], voffB[2];
#pragma unroll
    for (int i = 0; i < 2; ++i) { int R, C; stage_rc(tid * 16 + i * 8192, R, C); const int Rb = Epi::PERM ? ((R & ~31) + perm32(R & 31)) : R;
        voffA[i] = (unsigned)(R * lda + C) * 2u; voffB[i] = (unsigned)(Rb * K + C) * 2u; }
    const size_t kstep = (size_t)(BK * 2);
    const size_t hstepA = (size_t)HALF * lda * 2, hstepB = (size_t)HALF * K * 2;
    const size_t tstepA = 2 * hstepA, tstepB = 2 * hstepB;
    const unsigned ldsw = (unsigned)wid * 1024u;
    const int aoff = lds_byte(wr * 64 + fr, fq * 8), boff = lds_byte(wc * 32 + fr, fq * 8);
#define PG8_SA(b, h) (((b) * 2 + (h)) * HTB)
#define PG8_SB(b, h) ((4 + (b) * 2 + (h)) * HTB)
#define PG8_STAGE(bufoff, gbase, voff) do { _Pragma("unroll") for (int _i = 0; _i < 2; ++_i) \
        __builtin_amdgcn_global_load_lds((const unsigned*)((const char*)(gbase) + (voff)[_i]), (LAS unsigned*)(lds + (bufoff) + ldsw + _i * 8192), 16, 0, 0); } while (0)
#define PG8_LDA(dst, b, h) do { _Pragma("unroll") for (int m = 0; m < 4; ++m) _Pragma("unroll") for (int k = 0; k < 2; ++k) dst[m][k] = *(const LAS bf16x8*)(lds + PG8_SA(b, h) + aoff + m * 2048 + k * 1024); } while (0)
#define PG8_LDB(dst, b, h) do { _Pragma("unroll") for (int n = 0; n < 2; ++n) _Pragma("unroll") for (int k = 0; k < 2; ++k) dst[n][k] = *(const LAS bf16x8*)(lds + PG8_SB(b, h) + boff + n * 2048 + k * 1024); } while (0)
#define PG8_MMA(ai, bj, At, Bt) do { __builtin_amdgcn_s_setprio(1); _Pragma("unroll") for (int m = 0; m < 4; ++m) _Pragma("unroll") for (int n = 0; n < 2; ++n) _Pragma("unroll") for (int k = 0; k < 2; ++k) \
        acc[ai][bj][m][n] = __builtin_amdgcn_mfma_f32_16x16x32_bf16(Bt[n][k], At[m][k], acc[ai][bj][m][n], 0, 0, 0); __builtin_amdgcn_s_setprio(0); } while (0)
#define PG8_WAIT_V(n) asm volatile("s_waitcnt vmcnt(" #n ")" ::: "memory")
#define PG8_WAIT_L(n) asm volatile("s_waitcnt lgkmcnt(" #n ")" ::: "memory")
#define PG8_BAR __builtin_amdgcn_s_barrier()
#define PG8_SCHED __builtin_amdgcn_sched_barrier(0)
    Unit cur, nxt; int ui = 0;
    if (!S.next(0, cur)) return;
    f32x4 acc[2][2][4][2];
#pragma unroll
    for (int a = 0; a < 2; ++a)
#pragma unroll
        for (int b = 0; b < 2; ++b)
#pragma unroll
            for (int m = 0; m < 4; ++m)
#pragma unroll
                for (int n = 0; n < 2; ++n) acc[a][b][m][n] = (f32x4){0.f, 0.f, 0.f, 0.f};
    bf16x8 At[4][2], B0[2][2], B1[2][2];
    const char* cA = (const char*)g.A + (size_t)cur.pm * tstepA; const char* cB = (const char*)g.Bt + (size_t)cur.pn * tstepB;
    PG8_STAGE(PG8_SB(0, 0), cB, voffB); PG8_STAGE(PG8_SB(0, 1), cB + hstepB, voffB); PG8_STAGE(PG8_SA(0, 0), cA, voffA); PG8_STAGE(PG8_SA(0, 1), cA + hstepA, voffA);
    if (wr == 1) PG8_BAR;
    PG8_WAIT_V(2); PG8_BAR;
    PG8_STAGE(PG8_SB(1, 0), cB + kstep, voffB); PG8_STAGE(PG8_SA(1, 0), cA + kstep, voffA); PG8_STAGE(PG8_SB(1, 1), cB + hstepB + kstep, voffB);
    PG8_WAIT_V(6); PG8_BAR;
    for (;;) {
        const bool has_next = S.next(ui + 1, nxt);
        const char* nA = has_next ? (const char*)g.A + (size_t)nxt.pm * tstepA : cA; const char* nB = has_next ? (const char*)g.Bt + (size_t)nxt.pn * tstepB : cB;
#pragma unroll 1
        for (int t = 0; t < nt; t += 2) {
            const bool last = (t == nt - 2);
            const char* a1 = cA + (size_t)(t + 1) * kstep;
            const char* a2 = last ? nA : cA + (size_t)(t + 2) * kstep; const char* b2 = last ? nB : cB + (size_t)(t + 2) * kstep;
            const char* a3 = a2 + kstep; const char* b3 = b2 + kstep;
            PG8_LDB(B0, 0, 0); PG8_LDB(B1, 0, 1); PG8_SCHED; PG8_LDA(At, 0, 0); PG8_STAGE(PG8_SA(1, 1), a1 + hstepA, voffA);
            PG8_WAIT_V(8); PG8_WAIT_L(0); PG8_BAR; PG8_MMA(0, 0, At, B0); PG8_MMA(0, 1, At, B1); PG8_BAR; PG8_SCHED;
            PG8_LDA(At, 0, 1); PG8_STAGE(PG8_SB(0, 0), b2, voffB); PG8_STAGE(PG8_SB(0, 1), b2 + hstepB, voffB); PG8_STAGE(PG8_SA(0, 0), a2, voffA);
            PG8_WAIT_V(8); PG8_WAIT_L(0); PG8_BAR; PG8_MMA(1, 0, At, B0); PG8_MMA(1, 1, At, B1); PG8_BAR; PG8_SCHED;
            PG8_LDB(B0, 1, 0); PG8_LDB(B1, 1, 1); PG8_SCHED; PG8_LDA(At, 1, 0); PG8_STAGE(PG8_SA(0, 1), a2 + hstepA, voffA);
            PG8_WAIT_V(8); PG8_WAIT_L(0); PG8_BAR; PG8_MMA(0, 0, At, B0); PG8_MMA(0, 1, At, B1); PG8_BAR; PG8_SCHED;
            PG8_LDA(At, 1, 1); PG8_STAGE(PG8_SB(1, 0), b3, voffB); PG8_STAGE(PG8_SB(1, 1), b3 + hstepB, voffB); PG8_STAGE(PG8_SA(1, 0), a3, voffA);
            PG8_WAIT_V(8); PG8_WAIT_L(0); PG8_BAR; PG8_MMA(1, 0, At, B0); PG8_MMA(1, 1, At, B1); PG8_BAR; PG8_SCHED;
        }
        if constexpr (ALIGN_EPI) { if (wr == 0) PG8_BAR; }
        E(acc, cur, wr, wc, fr, fq);
        if (!has_next) break;
#pragma unroll
        for (int a = 0; a < 2; ++a)
#pragma unroll
            for (int b = 0; b < 2; ++b)
#pragma unroll
                for (int m = 0; m < 4; ++m)
#pragma unroll
                    for (int n = 0; n < 2; ++n) acc[a][b][m][n] = (f32x4){0.f, 0.f, 0.f, 0.f};
        cur = nxt; cA = nA; cB = nB; ++ui;
        if constexpr (ALIGN_EPI) { if (wr == 1) PG8_BAR; }
    }
    PG8_WAIT_V(0);
    if constexpr (!ALIGN_EPI) { if (wr == 0) PG8_BAR; }
    PG8_BAR;
#undef PG8_SA
#undef PG8_SB
#undef PG8_STAGE
#undef PG8_LDA
#undef PG8_LDB
#undef PG8_MMA
#undef PG8_WAIT_V
#undef PG8_WAIT_L
#undef PG8_BAR
#undef PG8_SCHED
}
}

__device__ __forceinline__ void modnorm_rows32(const float* X, bf16_t* O, const float* g, const float* sc, const float* sh, int m0, int lane, int nrows = 32) {
    f32x4 ga[4], hb[4];
#pragma unroll
    for (int j = 0; j < 4; ++j) { const int c = 4 * lane + 256 * j; ga[j] = *(const f32x4*)(g + c) * (*(const f32x4*)(sc + c) + 1.0f); hb[j] = *(const f32x4*)(sh + c); }
#pragma unroll 1
    for (int r0 = 0; r0 < nrows; r0 += 4) {
        f32x4 v[4][4]; float s[4];
#pragma unroll
        for (int i = 0; i < 4; ++i) { const f32x4* xr = (const f32x4*)(X + (size_t)(m0 + r0 + i) * DM) + lane;
#pragma unroll
            for (int j = 0; j < 4; ++j) v[i][j] = __builtin_nontemporal_load(xr + 64 * j); }
#pragma unroll
        for (int i = 0; i < 4; ++i) { s[i] = 0.f;
#pragma unroll
            for (int j = 0; j < 4; ++j) s[i] += (v[i][j][0] * v[i][j][0] + v[i][j][1] * v[i][j][1]) + (v[i][j][2] * v[i][j][2] + v[i][j][3] * v[i][j][3]); }
#pragma unroll
        for (int o = 1; o < 64; o <<= 1) {
#pragma unroll
            for (int i = 0; i < 4; ++i) s[i] += __shfl_xor(s[i], o); }
#pragma unroll
        for (int i = 0; i < 4; ++i) { const float rstd = 1.0f / sqrtf(s[i] * (1.0f / DM) + EPS); bf16_t* orow = O + (size_t)(m0 + r0 + i) * DM;
#pragma unroll
            for (int j = 0; j < 4; ++j) { const f32x4 y = v[i][j] * rstd * ga[j] + hb[j];
                u32x2 w; w.x = cvt_pk_bf16(y[0], y[1]); w.y = cvt_pk_bf16(y[2], y[3]);
                *(u32x2*)(orow + 4 * lane + 256 * j) = w; } }
    }
}

__device__ __forceinline__ void finalnorm_rows32(float* X, const float* g, int m0, int lane, int nrows = 32) {
    f32x4 gf[4];
#pragma unroll
    for (int j = 0; j < 4; ++j) gf[j] = *(const f32x4*)(g + 4 * lane + 256 * j);
#pragma unroll 1
    for (int r0 = 0; r0 < nrows; r0 += 4) {
        f32x4 v[4][4]; float s[4];
#pragma unroll
        for (int i = 0; i < 4; ++i) { const f32x4* xr = (const f32x4*)(X + (size_t)(m0 + r0 + i) * DM) + lane;
#pragma unroll
            for (int j = 0; j < 4; ++j) v[i][j] = xr[64 * j]; }
#pragma unroll
        for (int i = 0; i < 4; ++i) { s[i] = 0.f;
#pragma unroll
            for (int j = 0; j < 4; ++j) s[i] += (v[i][j][0] * v[i][j][0] + v[i][j][1] * v[i][j][1]) + (v[i][j][2] * v[i][j][2] + v[i][j][3] * v[i][j][3]); }
#pragma unroll
        for (int o = 1; o < 64; o <<= 1) {
#pragma unroll
            for (int i = 0; i < 4; ++i) s[i] += __shfl_xor(s[i], o); }
#pragma unroll
        for (int i = 0; i < 4; ++i) { const float rstd = 1.0f / sqrtf(s[i] * (1.0f / DM) + EPS); f32x4* xr = (f32x4*)(X + (size_t)(m0 + r0 + i) * DM) + lane;
#pragma unroll
            for (int j = 0; j < 4; ++j) xr[64 * j] = v[i][j] * rstd * gf[j]; }
    }
}
__device__ __forceinline__ void unpack8(const u32x4 w, f32x4& a, f32x4& b) {
    a[0] = __uint_as_float(w.x << 16); a[1] = __uint_as_float(w.x & 0xffff0000u); a[2] = __uint_as_float(w.y << 16); a[3] = __uint_as_float(w.y & 0xffff0000u);
    b[0] = __uint_as_float(w.z << 16); b[1] = __uint_as_float(w.z & 0xffff0000u); b[2] = __uint_as_float(w.w << 16); b[3] = __uint_as_float(w.w & 0xffff0000u);
}
__device__ __forceinline__ float wave_sum4(float (&s)[4]) {
#pragma unroll
    for (int o = 1; o < 64; o <<= 1) {
#pragma unroll
        for (int i = 0; i < 4; ++i) s[i] += __shfl_xor(s[i], o); }
    return 0.f;
}
__device__ __forceinline__ void modnorm_rows_b(const bf16_t* X, bf16_t* O, const float* g, const float* sc, const float* sh, int m0, int lane, int nrows) {
    f32x4 ga[4], hb[4];
#pragma unroll
    for (int j = 0; j < 4; ++j) { const int c = 8 * lane + 512 * (j >> 1) + 4 * (j & 1); ga[j] = *(const f32x4*)(g + c) * (*(const f32x4*)(sc + c) + 1.0f); hb[j] = *(const f32x4*)(sh + c); }
#pragma unroll 1
    for (int r0 = 0; r0 < nrows; r0 += 4) {
        u32x4 w[4][2]; f32x4 v[4][4]; float s[4];
#pragma unroll
        for (int i = 0; i < 4; ++i) { const u32x4* xr = (const u32x4*)(X + (size_t)(m0 + r0 + i) * DM) + lane; w[i][0] = xr[0]; w[i][1] = xr[64]; }
#pragma unroll
        for (int i = 0; i < 4; ++i) { unpack8(w[i][0], v[i][0], v[i][1]); unpack8(w[i][1], v[i][2], v[i][3]); s[i] = 0.f;
#pragma unroll
            for (int j = 0; j < 4; ++j) s[i] += (v[i][j][0] * v[i][j][0] + v[i][j][1] * v[i][j][1]) + (v[i][j][2] * v[i][j][2] + v[i][j][3] * v[i][j][3]); }
        wave_sum4(s);
#pragma unroll
        for (int i = 0; i < 4; ++i) { const float rstd = 1.0f / sqrtf(s[i] * (1.0f / DM) + EPS); u32x4* orow = (u32x4*)(O + (size_t)(m0 + r0 + i) * DM) + lane;
            const f32x4 y0 = v[i][0] * rstd * ga[0] + hb[0], y1 = v[i][1] * rstd * ga[1] + hb[1], y2 = v[i][2] * rstd * ga[2] + hb[2], y3 = v[i][3] * rstd * ga[3] + hb[3];
            orow[0] = pack8(y0, y1); orow[64] = pack8(y2, y3); }
    }
}
__device__ __forceinline__ void finalnorm_rows_b(const bf16_t* X, float* OUT, const float* g, int m0, int lane, int nrows) {
    f32x4 gf[4];
#pragma unroll
    for (int j = 0; j < 4; ++j) gf[j] = *(const f32x4*)(g + 8 * lane + 512 * (j >> 1) + 4 * (j & 1));
#pragma unroll 1
    for (int r0 = 0; r0 < nrows; r0 += 4) {
        u32x4 w[4][2]; f32x4 v[4][4]; float s[4];
#pragma unroll
        for (int i = 0; i < 4; ++i) { const u32x4* xr = (const u32x4*)(X + (size_t)(m0 + r0 + i) * DM) + lane; w[i][0] = xr[0]; w[i][1] = xr[64]; }
#pragma unroll
        for (int i = 0; i < 4; ++i) { unpack8(w[i][0], v[i][0], v[i][1]); unpack8(w[i][1], v[i][2], v[i][3]); s[i] = 0.f;
#pragma unroll
            for (int j = 0; j < 4; ++j) s[i] += (v[i][j][0] * v[i][j][0] + v[i][j][1] * v[i][j][1]) + (v[i][j][2] * v[i][j][2] + v[i][j][3] * v[i][j][3]); }
        wave_sum4(s);
#pragma unroll
        for (int i = 0; i < 4; ++i) { const float rstd = 1.0f / sqrtf(s[i] * (1.0f / DM) + EPS); f32x4* orow = (f32x4*)(OUT + (size_t)(m0 + r0 + i) * DM) + 2 * lane;
            orow[0] = v[i][0] * rstd * gf[0]; orow[1] = v[i][1] * rstd * gf[1]; orow[128] = v[i][2] * rstd * gf[2]; orow[129] = v[i][3] * rstd * gf[3]; }
    }
}

__device__ __forceinline__ bool panel_arrive_last(unsigned* cnt, int pm, unsigned ntiles, LAS unsigned char* lds) {
    asm volatile("s_waitcnt vmcnt(0)" ::: "memory");
    __syncthreads();
    LAS unsigned* flag = (LAS unsigned*)(lds + RING_BYTES + 64);
    if (threadIdx.x == 0) {
        const unsigned old = __hip_atomic_fetch_add(cnt + pm, 1u, __ATOMIC_RELAXED, __HIP_MEMORY_SCOPE_AGENT);
        const bool last = (old == ntiles - 1u);
        if (last) { __builtin_amdgcn_fence(__ATOMIC_ACQUIRE, "agent"); asm volatile("s_waitcnt vmcnt(0)" ::: "memory"); }
        *flag = last ? 1u : 0u;
    }
    __syncthreads();
    return *flag != 0u;
}

typedef const f32x4 (&AccRef)[2][2][4][2];

__device__ __forceinline__ void rope8(f32x4& v0, f32x4& v1, const float* cs, int t, int i0) {
    const f32x4 a = *(const f32x4*)(cs + ((size_t)t * 32 + i0) * 2), b = *(const f32x4*)(cs + ((size_t)t * 32 + i0 + 2) * 2);
    f32x4 o0, o1;
    o0[0] = v0[0] * a[0] - v0[1] * a[1]; o0[1] = v0[0] * a[1] + v0[1] * a[0];
    o0[2] = v0[2] * a[2] - v0[3] * a[3]; o0[3] = v0[2] * a[3] + v0[3] * a[2];
    o1[0] = v1[0] * b[0] - v1[1] * b[1]; o1[1] = v1[0] * b[1] + v1[1] * b[0];
    o1[2] = v1[2] * b[2] - v1[3] * b[3]; o1[3] = v1[2] * b[3] + v1[3] * b[2];
    v0 = o0; v1 = o1;
}

struct EpiInProj {
    static constexpr bool PERM = true;
    bf16_t* O; float* SS; const float* cs;
    __device__ __forceinline__ void operator()(AccRef acc, const pg8::Unit& u, int wr, int wc, int fr, int fq) const {
        const int row0 = u.pm * 256 + wr * 64 + fr, colt = u.pn * 256;
#pragma unroll
        for (int ai = 0; ai < 2; ++ai)
#pragma unroll
            for (int m = 0; m < 4; ++m) { const int row = row0 + ai * 128 + m * 16;
#pragma unroll
                for (int bj = 0; bj < 2; ++bj) {
                    f32x4 v0 = acc[ai][bj][m][0], v1 = acc[ai][bj][m][1];
                    const int slab = (colt + bj * 128 + wc * 32) >> 5;
                    if (slab >= 48 && slab < 68) {
                        float ss = (v0[0] * v0[0] + v0[1] * v0[1]) + (v0[2] * v0[2] + v0[3] * v0[3]) + (v1[0] * v1[0] + v1[1] * v1[1]) + (v1[2] * v1[2] + v1[3] * v1[3]);
                        ss += __shfl_xor(ss, 16); ss += __shfl_xor(ss, 32);
                        if (fq == 0) SS[(size_t)row * 20 + (slab - 48)] = ss;
                    }
                    if (slab < 16) { v0 = v0 * QS_DIFF; v1 = v1 * QS_DIFF; }
                    if (slab == 68 || slab == 69) rope8(v0, v1, cs, row & (SEQ - 1), (slab - 68) * 16 + fq * 4);
                    *(u32x4*)(O + (size_t)row * NPROJ + colt + bj * 128 + wc * 32 + 8 * fq) = pack8(v0, v1);
                } }
    }
};
struct EpiQUp {
    static constexpr bool PERM = true;
    bf16_t* O; const float* SS; const float* cs;
    __device__ __forceinline__ void operator()(AccRef acc, const pg8::Unit& u, int wr, int wc, int fr, int fq) const {
        const int row0 = u.pm * 256 + wr * 64 + fr, colt = u.pn * 256;
        float scl[2];
#pragma unroll
        for (int ai = 0; ai < 2; ++ai) { const float* sp = SS + (size_t)(u.pm * 256 + wr * 64 + ai * 128 + fq * 16 + fr) * 20;
            const f32x4 s0 = *(const f32x4*)(sp), s1 = *(const f32x4*)(sp + 4), s2 = *(const f32x4*)(sp + 8);
            const float ss = ((s0[0] + s0[1]) + (s0[2] + s0[3])) + ((s1[0] + s1[1]) + (s1[2] + s1[3])) + ((s2[0] + s2[1]) + (s2[2] + s2[3]));
            scl[ai] = QS_MLA / sqrtf(ss * (1.0f / KQ) + EPS); }
#pragma unroll
        for (int ai = 0; ai < 2; ++ai)
#pragma unroll
            for (int m = 0; m < 4; ++m) { const int row = row0 + ai * 128 + m * 16;
                const float sc = __shfl(scl[ai], m * 16 + fr);
#pragma unroll
                for (int bj = 0; bj < 2; ++bj) {
                    f32x4 v0 = acc[ai][bj][m][0] * sc, v1 = acc[ai][bj][m][1] * sc;
                    const int c0 = colt + bj * 128 + wc * 32 + 8 * fq, head = c0 / 192, within = c0 - head * 192;
                    if (within >= 128) rope8(v0, v1, cs, row & (SEQ - 1), (within - 128) >> 1);
                    *(u32x4*)(O + (size_t)row * NQ + c0) = pack8(v0, v1);
                } }
    }
};
struct EpiKvUp {
    static constexpr bool PERM = true;
    bf16_t* O; const float* SS;
    __device__ __forceinline__ void operator()(AccRef acc, const pg8::Unit& u, int wr, int wc, int fr, int fq) const {
        const int row0 = u.pm * 256 + wr * 64 + fr, colt = u.pn * 256;
        float scl[2];
#pragma unroll
        for (int ai = 0; ai < 2; ++ai) { const float* sp = SS + (size_t)(u.pm * 256 + wr * 64 + ai * 128 + fq * 16 + fr) * 20 + 12;
            const f32x4 s0 = *(const f32x4*)(sp), s1 = *(const f32x4*)(sp + 4);
            const float ss = ((s0[0] + s0[1]) + (s0[2] + s0[3])) + ((s1[0] + s1[1]) + (s1[2] + s1[3]));
            scl[ai] = 1.0f / sqrtf(ss * (1.0f / KKV) + EPS); }
#pragma unroll
        for (int ai = 0; ai < 2; ++ai)
#pragma unroll
            for (int m = 0; m < 4; ++m) { const int row = row0 + ai * 128 + m * 16;
                const float sc = __shfl(scl[ai], m * 16 + fr);
#pragma unroll
                for (int bj = 0; bj < 2; ++bj) {
                    const f32x4 v0 = acc[ai][bj][m][0] * sc, v1 = acc[ai][bj][m][1] * sc;
                    *(u32x4*)(O + (size_t)row * NKV + colt + bj * 128 + wc * 32 + 8 * fq) = pack8(v0, v1);
                } }
    }
};
__device__ __forceinline__ void panel_step(unsigned* cnt, int pmAnn, int pmWait) {
    asm volatile("s_waitcnt vmcnt(0)" ::: "memory");
    __syncthreads();
    if (threadIdx.x == 0) {
        if (pmAnn >= 0) (void)__hip_atomic_fetch_add(cnt + pmAnn, 1u, __ATOMIC_RELAXED, __HIP_MEMORY_SCOPE_AGENT);
        if (pmWait >= 0) { unsigned spins = 0;
            while (__hip_atomic_load(cnt + pmWait, __ATOMIC_RELAXED, __HIP_MEMORY_SCOPE_AGENT) < 4u) { __builtin_amdgcn_s_sleep(2); if (++spins > (1u << 16)) break; }
            __builtin_amdgcn_fence(__ATOMIC_ACQUIRE, "agent"); asm volatile("s_waitcnt vmcnt(0)" ::: "memory"); }
    }
    __syncthreads();
}
template <int MODE> struct EpiResGate {
    static constexpr bool PERM = true;
    const float* basef; const bf16_t* baseb; bf16_t* tile; const float* gate; unsigned* cnt; LAS unsigned char* lds; bf16_t* XN; float* OUT; const float* gn; const float* MODp;
    int pmA, pnA, pmB, pnB;
    __device__ __forceinline__ void rows(int pm, int pn, int nrq) const {
        const int lane = threadIdx.x & 63, wv = threadIdx.x >> 6, m0 = pm * 256 + pn * 64 + wv * nrq;
        if (MODE == 0) { const float* mb = MODp + (size_t)(m0 >> 11) * 6144; modnorm_rows_b(tile, XN, gn, mb + 4096, mb + 3072, m0, lane, nrq); }
        else finalnorm_rows_b(tile, OUT, gn, m0, lane, nrq);
    }
    __device__ __forceinline__ void operator()(AccRef acc, const pg8::Unit& u, int wr, int wc, int fr, int fq) {
        const bool fast = (gridDim.x == 256);
        int nbm = -1, nbn = 0;
        if (fast) { if (pmA >= 0) { panel_step(cnt, pmA, pmB); nbm = pmB; nbn = pnB; } pmB = pmA; pnB = pnA; }
        const int row0 = u.pm * 256 + wr * 64 + fr, colt = u.pn * 256;
        const float* gb = gate + (size_t)((u.pm * 256) >> 11) * 6144;
        const __amdgpu_buffer_rsrc_t rs = __builtin_amdgcn_make_buffer_rsrc((void*)tile, 0, TOK * DM * 2, 0x00020000);
#pragma unroll
        for (int bj = 0; bj < 2; ++bj) {
            const int c0 = colt + bj * 128 + wc * 32 + 8 * fq;
            const f32x4 g0 = *(const f32x4*)(gb + c0), g1 = *(const f32x4*)(gb + c0 + 4);
#pragma unroll
            for (int ai = 0; ai < 2; ++ai)
#pragma unroll
                for (int m = 0; m < 4; ++m) { const int row = row0 + ai * 128 + m * 16; const size_t off = (size_t)row * DM + c0;
                    f32x4 b0, b1;
                    if (MODE == 0) { b0 = __builtin_nontemporal_load((const f32x4*)(basef + off)); b1 = __builtin_nontemporal_load((const f32x4*)(basef + off + 4)); }
                    else unpack8(__builtin_nontemporal_load((const u32x4*)(baseb + off)), b0, b1);
                    const f32x4 o0 = b0 + g0 * acc[ai][bj][m][0], o1 = b1 + g1 * acc[ai][bj][m][1];
                    __builtin_amdgcn_raw_buffer_store_b128(pack8(o0, o1), rs, (unsigned)(off * 2), 0, 16); }
        }
        pmA = u.pm; pnA = u.pn;
        if (fast) { if (nbm >= 0) rows(nbm, nbn, 8); }
        else { const bool last = panel_arrive_last(cnt, u.pm, 4u, lds); rows(u.pm, 0, last ? 32 : 0); }
    }
    __device__ __forceinline__ void finish() {
        if (gridDim.x != 256) return;
        panel_step(cnt, pmA, pmB); if (pmB >= 0) rows(pmB, pnB, 8);
        panel_step(cnt, -1, pmA); if (pmA >= 0) rows(pmA, pnA, 8);
    }
};
struct EpiSwiGLU {
    static constexpr bool PERM = true;
    bf16_t* O;
    __device__ __forceinline__ void operator()(AccRef acc, const pg8::Unit& u, int wr, int wc, int fr, int fq) const {
        const int row0 = u.pm * 256 + wr * 64 + fr, c0 = u.pn * 128 + wc * 32 + 8 * fq;
#pragma unroll
        for (int ai = 0; ai < 2; ++ai)
#pragma unroll
            for (int m = 0; m < 4; ++m) { const int row = row0 + ai * 128 + m * 16;
                f32x4 r[2];
#pragma unroll
                for (int n = 0; n < 2; ++n) { const f32x4 gt = acc[ai][0][m][n], up = acc[ai][1][m][n];
#pragma unroll
                    for (int e = 0; e < 4; ++e) { const float sg = __builtin_amdgcn_rcpf(1.0f + __builtin_amdgcn_exp2f(-gt[e] * LOG2E)); r[n][e] = gt[e] * sg * up[e]; } }
                *(u32x4*)(O + (size_t)row * NFF + c0) = pack8(r[0], r[1]);
            }
    }
};

struct Args {
    const float *x, *c, *w_ada, *b_ada, *g_mix, *w_in, *lq1, *lk1, *lq2, *lk2, *g_diff_out, *g_q_lat, *w_q_up, *g_kv_lat, *w_kv_up, *w_out, *g_ffn, *w_gate, *w_up, *w_down, *g_final;
    float* out; unsigned char* ws; int ph_lo, ph_hi;
};

__device__ __forceinline__ int src_col(int mode, int n) {
    if (mode == 0) { if (n < 2176) return n; if (n >= 2240) return -1; const int j = n - 2176; return 2176 + (j >> 1) + 32 * (j & 1); }
    if (mode == 1) { const int head = n / 192, w = n - head * 192; if (w < 128) return n; const int j = w - 128; return head * 192 + 128 + (j >> 1) + 32 * (j & 1); }
    if (mode == 3) { return (n >> 8) * 128 + (n & 127); }
    return n;
}
__device__ __forceinline__ void transpose_item(const float* W, const float* W2, int K, int Nsrc, bf16_t* WT, int mode, const float* gain, LAS float* scr, int item, int nblk, int lane) {
    const int kb = item / nblk, nb = item % nblk, k0 = 64 * kb, n0 = 32 * nb;
    const int nn = n0 + (lane & 31), sc = src_col(mode, nn);
    const float* Wp = (mode == 3 && ((nn >> 7) & 1)) ? W2 : W;
#pragma unroll 16
    for (int i = 0; i < 32; ++i) { const int kk = 2 * i + (lane >> 5); float v = (sc >= 0) ? Wp[(size_t)(k0 + kk) * Nsrc + sc] : 0.f; if (gain) v *= gain[k0 + kk]; scr[kk * 33 + (lane & 31)] = v; }
    asm volatile("s_waitcnt lgkmcnt(0)" ::: "memory");
    const int c = lane & 7;
#pragma unroll
    for (int j = 0; j < 4; ++j) { const int n = (lane >> 3) + 8 * j; const LAS float* s = scr + (8 * c) * 33 + n;
        u32x4 o; o.x = pk2(s[0 * 33], s[1 * 33]); o.y = pk2(s[2 * 33], s[3 * 33]); o.z = pk2(s[4 * 33], s[5 * 33]); o.w = pk2(s[6 * 33], s[7 * 33]);
        *(u32x4*)(WT + (size_t)(n0 + n) * K + k0 + 8 * c) = o; }
    asm volatile("s_waitcnt lgkmcnt(0)" ::: "memory");
}
__device__ __forceinline__ void adaln_item(const Args& a, float* MOD, LAS unsigned char* lds, int item) {
    LAS float* L = (LAS float*)lds;
    const int tid = threadIdx.x, lane = tid & 63, wid = tid >> 6, j0 = item * 64;
#pragma unroll 16
    for (int i = 0; i < 64; ++i) { const int idx = tid + 512 * i, b = idx >> 10, k = idx & 1023; const float v = a.c[idx]; L[k * 32 + (b ^ ((k & 7) << 2))] = v / (1.0f + __expf(-v)); }
    __syncthreads();
    float acc[32];
#pragma unroll
    for (int b = 0; b < 32; ++b) acc[b] = 0.f;
#pragma unroll 16
    for (int kk = 0; kk < 128; ++kk) { const int k = wid * 128 + kk; const float wv = a.w_ada[(size_t)k * 6144 + j0 + lane];
#pragma unroll
        for (int b4 = 0; b4 < 8; ++b4) { const f32x4 cv = *(const LAS f32x4*)(L + k * 32 + 4 * (b4 ^ (kk & 7)));
            acc[4 * b4 + 0] += wv * cv[0]; acc[4 * b4 + 1] += wv * cv[1]; acc[4 * b4 + 2] += wv * cv[2]; acc[4 * b4 + 3] += wv * cv[3]; } }
    __syncthreads();
#pragma unroll
    for (int b = 0; b < 32; ++b) L[(wid * 32 + b) * 64 + lane] = acc[b];
    __syncthreads();
#pragma unroll
    for (int i = 0; i < 4; ++i) { const int o = tid + 512 * i, b = o >> 6, col = o & 63; float s = a.b_ada[j0 + col];
#pragma unroll
        for (int w = 0; w < 8; ++w) s += L[(w * 32 + b) * 64 + col];
        MOD[(size_t)b * 6144 + j0 + col] = s; }
    __syncthreads();
}
__device__ __forceinline__ s16x4 vtr(const LAS unsigned char* p) { return __builtin_bit_cast(s16x4, __builtin_amdgcn_ds_read_tr16_b64_v4i16((LAS s16x4*)p)); }

template <bool DIFF>
__device__ __forceinline__ void attn_unit(LAS unsigned char* lds, const bf16_t* PROJ, const bf16_t* QBUF, const bf16_t* KVB, bf16_t* MRG, const float* gdo, float lam, int b, int h, int qb) {
    constexpr int DQK = DIFF ? 64 : 192, NDS = DQK / 16, QB = DIFF ? 128 : 256;
    constexpr int POFF = 16384, VOFF = DIFF ? 16384 : 24576, STAGE = VOFF + 16384;
    constexpr float THR = 8.0f;
    const int tid = threadIdx.x, lane = tid & 63, r32 = lane & 31, hi = lane >> 5, wid = __builtin_amdgcn_readfirstlane(tid >> 6);
    const int map = DIFF ? (wid >> 2) : 0, wq = DIFF ? (wid & 3) : wid;
    const int q0 = qb * QB, qw0 = q0 + 32 * wq, qpos = qw0 + r32;
    const size_t rowbase = (size_t)b * SEQ;
    const int NT = (q0 + QB) / 64, tw = qw0 >> 6;
    bf16x8 qf[NDS];
    { const bf16_t* qp = DIFF ? PROJ + (rowbase + qpos) * NPROJ + h * 128 + map * 64 : QBUF + (rowbase + qpos) * NQ + h * 192;
#pragma unroll
      for (int ds = 0; ds < NDS; ++ds) qf[ds] = *(const bf16x8*)(qp + ds * 16 + hi * 8); }
    u32x4 qaug = (u32x4){0u, 0u, 0u, 0u}, kaug0 = qaug, kaug1 = qaug;
    if (DIFF) {
        const float c1 = LOG2E / (float)(1 << (2 * (h + 1))), c64 = 64.f * c1;
        const unsigned c1h = f2bf(c1), c1l = f2bf(c1 - __uint_as_float(c1h << 16)), c6h = f2bf(c64), c6l = f2bf(c64 - __uint_as_float(c6h << 16));
        const unsigned j0 = __float_as_uint((float)r32) >> 16, j1 = __float_as_uint((float)(r32 + 32)) >> 16;
        if (hi == 0) { qaug.x = c1h | (c1l << 16); qaug.y = c6h | (c6l << 16); kaug0.x = j0 | (j0 << 16); kaug1.x = j1 | (j1 << 16); }
    }
    f32x16 o[4];
#pragma unroll
    for (int d0 = 0; d0 < 4; ++d0)
#pragma unroll
        for (int r = 0; r < 16; ++r) o[d0][r] = 0.f;
    f32x16 negm;
#pragma unroll
    for (int r = 0; r < 16; ++r) negm[r] = 0.f;
    float mrun = 0.f, lrun = 0.f;
    constexpr size_t PITCH = DIFF ? NPROJ : NKV;
    const int Lrr = (lane >> 2) & 7, Lsub = lane >> 5, Lslot = lane & 3;
    const int xr = (2 * ((wid >> 1) & 1) + (Lrr >> 2)) & 3, xp = (2 * (wid & 1) + (Lrr >> 2)) & 3;
    const int rowA = 8 * (wid >> 1) + Lrr, chA = 4 * (2 * (wid & 1) + Lsub) + (Lslot ^ xr);
    const bf16_t* gK = (DIFF ? PROJ + (rowbase + rowA) * NPROJ + 512 + h * 128 : KVB + (rowbase + rowA) * NKV + h * 256) + chA * 8;
    const bf16_t* gV = (DIFF ? PROJ + (rowbase + rowA) * NPROJ + 1024 + h * 128 : KVB + (rowbase + rowA) * NKV + h * 256 + 128) + chA * 8;
    const bf16_t* gP = PROJ + (rowbase + 8 * wid + Lrr) * NPROJ + 2176 + (4 * Lsub + (Lslot ^ xp)) * 8;
    const int dW = wid * 1024;
#define ATT_DMA(src, dst) __builtin_amdgcn_global_load_lds((const unsigned*)(src), (LAS unsigned*)(dst), 16, 0, 0)
#define ATT_LOAD(t, st) do { const size_t ro_ = (size_t)(t) * 64 * PITCH; LAS unsigned char* sb_ = lds + (st) * STAGE + dW; \
        ATT_DMA(gK + ro_, sb_); ATT_DMA(gK + ro_ + 32 * PITCH, sb_ + 8192); \
        ATT_DMA(gV + ro_, sb_ + VOFF); ATT_DMA(gV + ro_ + 32 * PITCH, sb_ + VOFF + 8192); \
        if (!DIFF) ATT_DMA(gP + (size_t)(t) * 64 * NPROJ, sb_ + POFF); } while (0)
#define ATT_BAR() do { asm volatile("" ::: "memory"); __builtin_amdgcn_s_barrier(); asm volatile("" ::: "memory"); } while (0)
#define SB() __builtin_amdgcn_sched_barrier(0)
    const int xq = (r32 >> 2) & 3;
    const int kb0 = 2048 * (r32 >> 3) + 64 * (r32 & 7) + 1024 * map + 16 * (hi ^ xq), kb1 = kb0 ^ 32;
    const int pb0 = POFF + 1024 * (r32 >> 3) + 64 * (r32 & 7) + 16 * (hi ^ xq), pb1 = pb0 ^ 32;
    const int vq = (lane & 15) >> 2, vp = lane & 3;
    const int vb0 = VOFF + 64 * (4 * hi + vq) + 16 * ((2 * ((lane >> 4) & 1)) | ((vp >> 1) ^ hi)) + 8 * (vp & 1), vb1 = vb0 ^ 32;
#define KFR(ds, hh) (*(const LAS bf16x8*)(sb + (((ds) & 1) ? kb1 : kb0) + 8192 * (hh) + 512 * ((ds) >> 1)))
#define PFR(dp, hh) (*(const LAS bf16x8*)(sb + (((dp) & 1) ? pb1 : pb0) + 4096 * (hh) + 512 * ((dp) >> 1)))
#define KMLA(ds, hh) ((ds) < 8 ? KFR(ds, hh) : PFR((ds) - 8, hh))
#define VTR(dst, addr, off) asm volatile("ds_read_b64_tr_b16 %0, %1 offset:%2" : "=v"(dst) : "v"(addr), "i"(off) : "memory")
    asm volatile("s_waitcnt lgkmcnt(0)" ::: "memory");
    ATT_BAR();
    ATT_LOAD(NT - 1, 0);
    if (NT > 1) ATT_LOAD(NT - 2, 1);
    bool first = true;
    int st = 0, st2 = 2;
    for (int it = 0; it < NT; ++it) {
        const int t = NT - 1 - it;
        if (it + 1 < NT) { if (DIFF) asm volatile("s_waitcnt vmcnt(4)" ::: "memory"); else asm volatile("s_waitcnt vmcnt(5)" ::: "memory"); }
        else asm volatile("s_waitcnt vmcnt(0)" ::: "memory");
        ATT_BAR();
        if (it + 2 < NT) ATT_LOAD(t - 2, st2);
        if (t <= tw) {
            const LAS unsigned char* sb = lds + st * STAGE;
            f32x16 s0, s1;
            if (DIFF) {
                bf16x8 kf[8];
#pragma unroll
                for (int i = 0; i < 4; ++i) { kf[2 * i] = KFR(i, 0); kf[2 * i + 1] = KFR(i, 1); }
                SB();
                const unsigned tb = __float_as_uint((float)t) >> 16;
                if (hi == 0) { kaug0.y = tb | (tb << 16); kaug1.y = kaug0.y; }
                __builtin_amdgcn_s_setprio(1);
                s0 = __builtin_amdgcn_mfma_f32_32x32x16_bf16(__builtin_bit_cast(bf16x8, kaug0), __builtin_bit_cast(bf16x8, qaug), negm, 0, 0, 0);
                s1 = __builtin_amdgcn_mfma_f32_32x32x16_bf16(__builtin_bit_cast(bf16x8, kaug1), __builtin_bit_cast(bf16x8, qaug), negm, 0, 0, 0);
#pragma unroll
                for (int ds = 0; ds < 4; ++ds) {
                    s0 = __builtin_amdgcn_mfma_f32_32x32x16_bf16(kf[2 * ds], qf[ds], s0, 0, 0, 0);
                    s1 = __builtin_amdgcn_mfma_f32_32x32x16_bf16(kf[2 * ds + 1], qf[ds], s1, 0, 0, 0);
                }
                __builtin_amdgcn_s_setprio(0);
            } else {
                bf16x8 kf[4];
#pragma unroll
                for (int i = 0; i < 2; ++i) { kf[2 * i] = KFR(i, 0); kf[2 * i + 1] = KFR(i, 1); }
#pragma unroll
                for (int g = 0; g < 6; ++g) {
                    bf16x8 kn[4];
                    if (g < 5) {
#pragma unroll
                        for (int i = 0; i < 2; ++i) { kn[2 * i] = KMLA(2 * g + 2 + i, 0); kn[2 * i + 1] = KMLA(2 * g + 2 + i, 1); }
                    }
                    SB();
                    __builtin_amdgcn_s_setprio(1);
                    if (g == 0) { s0 = __builtin_amdgcn_mfma_f32_32x32x16_bf16(kf[0], qf[0], negm, 0, 0, 0); s1 = __builtin_amdgcn_mfma_f32_32x32x16_bf16(kf[1], qf[0], negm, 0, 0, 0); }
                    else { s0 = __builtin_amdgcn_mfma_f32_32x32x16_bf16(kf[0], qf[2 * g], s0, 0, 0, 0); s1 = __builtin_amdgcn_mfma_f32_32x32x16_bf16(kf[1], qf[2 * g], s1, 0, 0, 0); }
                    s0 = __builtin_amdgcn_mfma_f32_32x32x16_bf16(kf[2], qf[2 * g + 1], s0, 0, 0, 0); s1 = __builtin_amdgcn_mfma_f32_32x32x16_bf16(kf[3], qf[2 * g + 1], s1, 0, 0, 0);
                    __builtin_amdgcn_s_setprio(0);
                    SB();
                    if (g < 5) {
#pragma unroll
                        for (int i = 0; i < 4; ++i) kf[i] = kn[i];
                    }
                }
            }
            s16x4 vl[4][4], vh[4][4];
            const unsigned va0 = (unsigned)(uintptr_t)(sb + vb0), va1 = (unsigned)(uintptr_t)(sb + vb1);
#pragma unroll
            for (int s = 0; s < 2; ++s)
#pragma unroll
                for (int d0 = 0; d0 < 4; ++d0) { VTR(vl[s][d0], va0, s * 4096 + d0 * 512); VTR(vh[s][d0], va1, s * 4096 + 2048 + d0 * 512); }
            SB();
            if (t == tw) {
                const int kvl = 64 * t + 4 * hi - qpos;
#pragma unroll
                for (int r = 0; r < 16; ++r) { const int cr = (r & 3) + 8 * (r >> 2); if (kvl + cr > 0) s0[r] = -1e30f; if (kvl + cr + 32 > 0) s1[r] = -1e30f; }
            }
            float mx = fmaxf(s0[0], s1[0]);
#pragma unroll
            for (int r = 1; r < 16; ++r) mx = fmaxf(fmaxf(mx, s0[r]), s1[r]);
            mx = fmaxf(mx, __shfl_xor(mx, 32));
            if (first || __any(mx > THR)) {
                const float dl = first ? mx : fmaxf(mx, 0.f);
                mrun += dl;
#pragma unroll
                for (int r = 0; r < 16; ++r) { s0[r] -= dl; s1[r] -= dl; negm[r] = -mrun; }
                asm volatile("" : "+v"(negm));
                if (!first) { const float f = __builtin_amdgcn_exp2f(-dl); lrun *= f;
#pragma unroll
                    for (int d0 = 0; d0 < 4; ++d0)
#pragma unroll
                        for (int r = 0; r < 16; ++r) o[d0][r] *= f; }
                first = false;
            }
            float ls = 0.f;
#pragma unroll
            for (int r = 0; r < 16; ++r) { s0[r] = __builtin_amdgcn_exp2f(s0[r]); s1[r] = __builtin_amdgcn_exp2f(s1[r]); ls += s0[r]; ls += s1[r]; }
            lrun += ls;
            u32x4 pw[4];
#pragma unroll
            for (int j = 0; j < 4; ++j) { pw[0][j] = cvt_pk_bf16(s0[2 * j], s0[2 * j + 1]); pw[1][j] = cvt_pk_bf16(s0[8 + 2 * j], s0[8 + 2 * j + 1]);
                                          pw[2][j] = cvt_pk_bf16(s1[2 * j], s1[2 * j + 1]); pw[3][j] = cvt_pk_bf16(s1[8 + 2 * j], s1[8 + 2 * j + 1]); }
            asm volatile("s_waitcnt lgkmcnt(0)" ::: "memory");
#pragma unroll
            for (int s = 2; s < 4; ++s)
#pragma unroll
                for (int d0 = 0; d0 < 4; ++d0) { VTR(vl[s][d0], va0, s * 4096 + d0 * 512); VTR(vh[s][d0], va1, s * 4096 + 2048 + d0 * 512); }
            SB();
#pragma unroll
            for (int s = 0; s < 4; ++s) {
                if (s == 2) { asm volatile("s_waitcnt lgkmcnt(0)" ::: "memory"); SB(); }
                __builtin_amdgcn_s_setprio(1);
#pragma unroll
                for (int d0 = 0; d0 < 4; ++d0) {
                    const bf16x8 vf = __builtin_shufflevector(vl[s][d0], vh[s][d0], 0, 1, 2, 3, 4, 5, 6, 7);
                    o[d0] = __builtin_amdgcn_mfma_f32_32x32x16_bf16(vf, __builtin_bit_cast(bf16x8, pw[s]), o[d0], 0, 0, 0);
                }
                __builtin_amdgcn_s_setprio(0);
            }
            SB();
        }
        st = (st == 2) ? 0 : st + 1; st2 = (st2 == 2) ? 0 : st2 + 1;
    }
    asm volatile("s_waitcnt lgkmcnt(0)" ::: "memory");
    ATT_BAR();
#undef ATT_DMA
#undef ATT_LOAD
#undef SB
#undef KFR
#undef PFR
#undef KMLA
#undef VTR
    const float inv = 1.0f / (lrun + __shfl_xor(lrun, 32));
    if (DIFF) {
        LAS float* X = (LAS float*)lds + (size_t)(wq * 64) * 64 + lane;
        if (map == 1) {
#pragma unroll
            for (int d0 = 0; d0 < 4; ++d0)
#pragma unroll
                for (int r = 0; r < 16; ++r) X[(d0 * 16 + r) * 64] = o[d0][r] * inv;
        }
        asm volatile("s_waitcnt lgkmcnt(0)" ::: "memory");
        ATT_BAR();
        if (map == 0) {
            float ss = 0.f;
#pragma unroll
            for (int d0 = 0; d0 < 4; ++d0)
#pragma unroll
                for (int r = 0; r < 16; ++r) { const float v = o[d0][r] * inv - lam * X[(d0 * 16 + r) * 64]; o[d0][r] = v; ss += v * v; }
            ss += __shfl_xor(ss, 32);
            const float rs = (1.0f - LAMBDA_INIT) / sqrtf(ss * (1.0f / 128.f) + EPS);
            bf16_t* op = MRG + (rowbase + qpos) * DM + h * 128;
#pragma unroll
            for (int d0 = 0; d0 < 4; ++d0)
#pragma unroll
                for (int gp = 0; gp < 2; ++gp) {
                    u32x2 w[2];
#pragma unroll
                    for (int k = 0; k < 2; ++k) { const int g = 2 * gp + k, d = 32 * d0 + 8 * g + 4 * hi; const f32x4 gg = *(const f32x4*)(gdo + d);
                        w[k].x = cvt_pk_bf16(o[d0][4 * g] * rs * gg[0], o[d0][4 * g + 1] * rs * gg[1]); w[k].y = cvt_pk_bf16(o[d0][4 * g + 2] * rs * gg[2], o[d0][4 * g + 3] * rs * gg[3]); }
                    const u32x2 snd = hi ? w[0] : w[1]; u32x2 rcv; rcv.x = __shfl_xor(snd.x, 32); rcv.y = __shfl_xor(snd.y, 32);
                    const u32x4 c = hi ? (u32x4){rcv.x, rcv.y, w[1].x, w[1].y} : (u32x4){w[0].x, w[0].y, rcv.x, rcv.y};
                    *(u32x4*)(op + 32 * d0 + 8 * (2 * gp + hi)) = c; }
        }
    } else {
        bf16_t* op = MRG + (rowbase + qpos) * DM + 512 + h * 128;
#pragma unroll
        for (int d0 = 0; d0 < 4; ++d0)
#pragma unroll
            for (int gp = 0; gp < 2; ++gp) {
                u32x2 w[2];
#pragma unroll
                for (int k = 0; k < 2; ++k) { const int g = 2 * gp + k;
                    w[k].x = cvt_pk_bf16(o[d0][4 * g] * inv, o[d0][4 * g + 1] * inv); w[k].y = cvt_pk_bf16(o[d0][4 * g + 2] * inv, o[d0][4 * g + 3] * inv); }
                const u32x2 snd = hi ? w[0] : w[1]; u32x2 rcv; rcv.x = __shfl_xor(snd.x, 32); rcv.y = __shfl_xor(snd.y, 32);
                const u32x4 c = hi ? (u32x4){rcv.x, rcv.y, w[1].x, w[1].y} : (u32x4){w[0].x, w[0].y, rcv.x, rcv.y};
                *(u32x4*)(op + 32 * d0 + 8 * (2 * gp + hi)) = c; }
    }
#undef ATT_BAR
}

#define XB_TMO      128
#define XB_XCNT(j)  (256  + 64 * (j))
#define XB_XSUB(j)  (1280 + 64 * (j))
#define XB_XGEN(j)  (2304 + 64 * (j))
#define XB_TOP      3328
#define XB_TOPGEN   3392
#define XCD_BAR_WORDS 3456
#define XB_SPIN_CAP (1u << 18)

__device__ __forceinline__ unsigned xb_ld(unsigned* p)              { return __hip_atomic_load(p, __ATOMIC_RELAXED, __HIP_MEMORY_SCOPE_AGENT); }
__device__ __forceinline__ unsigned xb_add(unsigned* p, unsigned v) { return __hip_atomic_fetch_add(p, v, __ATOMIC_RELAXED, __HIP_MEMORY_SCOPE_AGENT); }
__device__ __forceinline__ unsigned xb_xcc_id() { return (unsigned)__builtin_amdgcn_s_getreg((3 << 11) | 20) & 0xFu; }
#define XB_SPIN(cond, bar) do { unsigned _sp = 0; while (cond) { __builtin_amdgcn_s_sleep(1); \
    if ((++_sp & 255u) == 0u) { if (xb_ld(&(bar)[XB_TMO])) break; if (_sp > XB_SPIN_CAP) { atomicAdd(&(bar)[XB_TMO], 1u); break; } } } } while (0)

struct XcdBarrier {
    unsigned* bar; unsigned x;
    volatile LAS unsigned* st;
};

__device__ __forceinline__ XcdBarrier xcd_barrier_post(unsigned* bar, volatile LAS unsigned* st) {
    XcdBarrier b; b.bar = bar; b.x = xb_xcc_id(); b.st = st;
    if (threadIdx.x == 0) (void)xb_add(&bar[XB_XCNT(b.x)], 1u);
    return b;
}
__device__ __forceinline__ void xcd_barrier_complete(unsigned* bar, unsigned x, unsigned& nloc, unsigned& nx) {
    const unsigned G = gridDim.x * gridDim.y * gridDim.z;
    unsigned sum, cnt, mine, sp = 0u;
    for (;;) {
        sum = 0u; cnt = 0u; mine = 0u;
#pragma unroll
        for (unsigned j = 0; j < 16; ++j) { const unsigned c = xb_ld(&bar[XB_XCNT(j)]); sum += c; cnt += (c > 0u) ? 1u : 0u; mine = (j == x) ? c : mine; }
        if (sum == G) break;
        __builtin_amdgcn_s_sleep(1);
        if ((++sp & 255u) == 0u) { if (xb_ld(&bar[XB_TMO])) break; if (sp > XB_SPIN_CAP) { atomicAdd(&bar[XB_TMO], 1u); break; } }
    }
    nloc = mine > 0u ? mine : 1u; nx = cnt > 0u ? cnt : 1u;
}

__device__ __forceinline__ void xcd_barrier(const XcdBarrier& b) {
    asm volatile("s_waitcnt vmcnt(0)" ::: "memory");
    __syncthreads();
    if (threadIdx.x == 0) {
        unsigned* bar = b.bar;
        __builtin_amdgcn_s_waitcnt(0);
        unsigned nloc = b.st[0], nx = b.st[1];
        if (nloc == 0u) { xcd_barrier_complete(bar, b.x, nloc, nx); b.st[0] = nloc; b.st[1] = nx; }
        const unsigned old = xb_add(&bar[XB_XSUB(b.x)], 1u);
        const unsigned gen = old / nloc;
        if (old + 1u == (gen + 1u) * nloc) {
            __builtin_amdgcn_fence(__ATOMIC_RELEASE, "agent");
            asm volatile("s_waitcnt vmcnt(0)" ::: "memory");
            const unsigned og = xb_add(&bar[XB_TOP], 1u);
            const unsigned tg = og / nx;
            if (og + 1u == (tg + 1u) * nx) xb_add(&bar[XB_TOPGEN], 1u);
            else XB_SPIN(xb_ld(&bar[XB_TOPGEN]) == tg, bar);
            __builtin_amdgcn_fence(__ATOMIC_ACQUIRE, "agent");
            xb_add(&bar[XB_XGEN(b.x)], 1u);
            asm volatile("s_waitcnt vmcnt(0)" ::: "memory");
        } else {
            XB_SPIN(xb_ld(&bar[XB_XGEN(b.x)]) == gen, bar);
            __builtin_amdgcn_fence(__ATOMIC_ACQUIRE, "agent");
            asm volatile("s_waitcnt vmcnt(0)" ::: "memory");
        }
    }
    __syncthreads();
}


__global__ void __launch_bounds__(512, 2) fwd_kernel(Args a) {
    extern __shared__ __attribute__((aligned(16))) unsigned char lds_raw[];
    LAS unsigned char* lds = (LAS unsigned char*)lds_raw;
    cg::grid_group grid = cg::this_grid();
    const int tid = threadIdx.x, lane = tid & 63, wave = __builtin_amdgcn_readfirstlane(tid >> 6);
    const int G = gridDim.x, bx = blockIdx.x, vcu = (G % 8 == 0) ? (bx % 8) * (G / 8) + bx / 8 : bx;
    unsigned char* ws = a.ws;
    bf16_t *WIN = (bf16_t*)(ws + WS_WIN), *WQ = (bf16_t*)(ws + WS_WQ), *WKV = (bf16_t*)(ws + WS_WKV), *WOUT = (bf16_t*)(ws + WS_WOUT), *WGU = (bf16_t*)(ws + WS_WGU), *WDN = (bf16_t*)(ws + WS_WDN);
    float *MOD = (float*)(ws + WS_MOD), *CS = (float*)(ws + WS_CS), *SS = (float*)(ws + WS_SS); unsigned* CNT = (unsigned*)(ws + WS_SS2);
    bf16_t *XN = (bf16_t*)(ws + WS_XN), *PROJ = (bf16_t*)(ws + WS_PROJ), *QBUF = (bf16_t*)(ws + WS_Q), *KVB = (bf16_t*)(ws + WS_KV), *MRG = (bf16_t*)(ws + WS_MRG), *ACT = (bf16_t*)(ws + WS_ACT);
    bf16_t *X1B = KVB, *X2B = XN;
    const int lo = a.ph_lo, hi = a.ph_hi;
#ifndef PH_MASK
#define PH_MASK 0x3ff
#endif
#define IN(k) (((PH_MASK >> (k)) & 1) && lo <= (k) && (k) < hi)
    volatile LAS unsigned* xst = (volatile LAS unsigned*)(lds + RING_BYTES + 128);
    if (tid == 0) { xst[0] = 0u; xst[1] = 0u; }
    XcdBarrier xbar; xbar.bar = (unsigned*)ws; xbar.x = 0; xbar.st = xst;
#define SEAM(k) do { if (IN((k) + 1)) { if ((k) == 0) { grid.sync(); xbar = xcd_barrier_post((unsigned*)ws, xst); } else xcd_barrier(xbar); } } while (0)

    if (IN(0)) {
        if (bx == G - 1) { CNT[tid] = 0u; for (int i = tid; i < XCD_BAR_WORDS; i += 512) ((unsigned*)ws)[i] = 0u; }
        for (int it = bx; it < 96; it += G) adaln_item(a, MOD, lds, it);
        LAS float* scr = (LAS float*)(lds + wave * 16384);
        const int tfirst = (G > 128) ? 96 : 0;
        const int gw = (bx - tfirst) * 8 + wave, NGW = (G - tfirst) * 8;
        constexpr int I_IN = 16 * 72, I_Q = 6 * 24, I_KV = 4 * 32, I_O = 16 * 32, I_GU = 16 * 176, I_DN = 44 * 32;
        constexpr int NITEMS = I_IN + I_Q + I_KV + I_O + I_GU + I_DN;
        for (int it = (bx >= tfirst) ? gw : NITEMS; it < NITEMS; it += NGW) {
            int r = it;
            if (r < I_IN) { transpose_item(a.w_in, nullptr, 1024, 2240, WIN, 0, nullptr, scr, r, 72, lane); continue; } r -= I_IN;
            if (r < I_Q) { transpose_item(a.w_q_up, nullptr, KQ, NQ, WQ, 1, a.g_q_lat, scr, r, 24, lane); continue; } r -= I_Q;
            if (r < I_KV) { transpose_item(a.w_kv_up, nullptr, KKV, NKV, WKV, 2, a.g_kv_lat, scr, r, 32, lane); continue; } r -= I_KV;
            if (r < I_O) { transpose_item(a.w_out, nullptr, 1024, 1024, WOUT, 2, nullptr, scr, r, 32, lane); continue; } r -= I_O;
            if (r < I_GU) { transpose_item(a.w_gate, a.w_up, 1024, NFF, WGU, 3, nullptr, scr, r, 176, lane); continue; } r -= I_GU;
            transpose_item(a.w_down, nullptr, NFF, 1024, WDN, 2, nullptr, scr, r, 32, lane);
        }
        for (int e = bx * 512 + tid; e < SEQ * 32; e += G * 512) {
            const int t = e >> 5, i = e & 31;
            const float invf = __builtin_amdgcn_exp2f(-(float)i * (13.287712379549449f / 32.0f));
            const float ang = (float)t * invf;
            const double ad = (double)ang, kk = __builtin_rint(ad * 0.15915494309189535);
            const float rr = (float)(ad - kk * 6.283185307179586);
            CS[2 * e] = __cosf(rr); CS[2 * e + 1] = __sinf(rr);
        }
        SEAM(0);
    }
    if (IN(1)) {
        const int gw = vcu * 8 + wave, NGW = G * 8;
        for (int m = gw * 32; m < TOK; m += NGW * 32) { const float* mb = MOD + (size_t)(m >> 11) * 6144; modnorm_rows32(a.x, XN, a.g_mix, mb + 1024, mb, m, lane); }
        SEAM(1);
    }
    if (IN(2)) {
        pg8::Gemm g{XN, WIN, TOK, NPROJ, 1024, 1024}; pg8::StaticOrder S; S.init(TOK, NPROJ, G, bx);
        EpiInProj E{PROJ, SS, CS};
        pg8::gemm_phase<EpiInProj, true>(lds, g, S, E);
        SEAM(2);
    }
    if (IN(3)) {
        { pg8::Gemm g{PROJ + 1536, WQ, TOK, NQ, KQ, NPROJ}; pg8::StaticOrder S; S.init(TOK, NQ, G, bx); EpiQUp E{QBUF, SS, CS}; pg8::gemm_phase<EpiQUp, true>(lds, g, S, E); }
        { pg8::Gemm g{PROJ + 1920, WKV, TOK, NKV, KKV, NPROJ}; pg8::StaticOrder S; S.init(TOK, NKV, G, bx); EpiKvUp E{KVB, SS}; pg8::gemm_phase<EpiKvUp, true>(lds, g, S, E); }
        SEAM(3);
    }
    if (IN(4)) {
        float d1 = a.lq1[lane] * a.lk1[lane], d2 = a.lq2[lane] * a.lk2[lane];
        const float lam = __expf(wave_sum(d1)) - __expf(wave_sum(d2)) + LAMBDA_INIT;
        for (int p = vcu * 4; p < 1024; p += G * 4)
            for (int i = 0; i < 4 && p + i < 1024; ++i) { const int pp = p + i, bh = pp >> 3, pr = pp & 7;
                attn_unit<true>(lds, PROJ, QBUF, KVB, MRG, a.g_diff_out, lam, bh >> 2, bh & 3, 15 - pr);
                attn_unit<true>(lds, PROJ, QBUF, KVB, MRG, a.g_diff_out, lam, bh >> 2, bh & 3, pr); }
        for (int p = vcu * 2; p < 512; p += G * 2)
            for (int i = 0; i < 2 && p + i < 512; ++i) { const int pp = p + i, bh = pp >> 2, pr = pp & 3;
                attn_unit<false>(lds, PROJ, QBUF, KVB, MRG, a.g_diff_out, lam, bh >> 2, bh & 3, 7 - pr);
                attn_unit<false>(lds, PROJ, QBUF, KVB, MRG, a.g_diff_out, lam, bh >> 2, bh & 3, pr); }
        __syncthreads();
        SEAM(4);
    }
    if (IN(5)) {
        pg8::Gemm g{MRG, WOUT, TOK, 1024, 1024, 1024}; pg8::StaticOrder S; S.init(TOK, 1024, G, bx);
        EpiResGate<0> E{a.x, nullptr, X1B, MOD + 2048, CNT, lds, XN, nullptr, a.g_ffn, MOD, -1, 0, -1, 0};
        pg8::gemm_phase<EpiResGate<0>, true>(lds, g, S, E);
        E.finish();
        if (IN(7)) xcd_barrier(xbar);
    }
    if (IN(7)) {
        pg8::Gemm g{XN, WGU, TOK, NGU, 1024, 1024}; pg8::StaticOrder S; S.init(TOK, NGU, G, bx);
        EpiSwiGLU E{ACT};
        pg8::gemm_phase<EpiSwiGLU, true>(lds, g, S, E);
        SEAM(7);
    }
    if (IN(8)) {
        pg8::Gemm g{ACT, WDN, TOK, 1024, NFF, NFF}; pg8::StaticOrder S; S.init(TOK, 1024, G, bx);
        EpiResGate<1> E{nullptr, X1B, X2B, MOD + 5120, CNT + 256, lds, nullptr, a.out, a.g_final, MOD, -1, 0, -1, 0};
        pg8::gemm_phase<EpiResGate<1>, true>(lds, g, S, E);
        E.finish();
    }
#undef IN
#undef SEAM
}

extern "C" void kernel_launch(void* const* d_in, const int* in_sizes, int n_in, void* d_out, int out_size, void* d_ws, size_t ws_size, hipStream_t stream) {
    static int grid = 0;
    if (grid == 0) {
        if (n_in != 21 || in_sizes[0] != TOK * DM || out_size != TOK * DM || ws_size < WS_END) { fprintf(stderr, "kernel_launch: unexpected shapes (n_in %d, ws %zu)\n", n_in, ws_size); grid = -1; return; }
        int dev = 0, cus = 0, per_cu = 0;
        if (hipGetDevice(&dev) != hipSuccess || hipDeviceGetAttribute(&cus, hipDeviceAttributeMultiprocessorCount, dev) != hipSuccess) { grid = -1; return; }
        if (hipFuncSetAttribute((const void*)fwd_kernel, hipFuncAttributeMaxDynamicSharedMemorySize, LDS_BYTES) != hipSuccess) { fprintf(stderr, "kernel_launch: hipFuncSetAttribute failed\n"); grid = -1; return; }
        if (hipOccupancyMaxActiveBlocksPerMultiprocessor(&per_cu, (const void*)fwd_kernel, 512, LDS_BYTES) != hipSuccess || per_cu < 1) { fprintf(stderr, "kernel_launch: occupancy query gave %d\n", per_cu); per_cu = 1; }
        (void)hipGetLastError();
        grid = cus * (per_cu > 1 ? 1 : per_cu);
    }
    if (grid < 0) return;
    Args a{};
    const float** fp = (const float**)&a;
    for (int i = 0; i < 21; ++i) fp[i] = (const float*)d_in[i];
    a.out = (float*)d_out; a.ws = (unsigned char*)d_ws;
#if MK_NL == 1
    a.ph_lo = 0; a.ph_hi = 10;
    void* args[] = {&a};
    hipError_t e = hipLaunchCooperativeKernel((const void*)fwd_kernel, dim3(grid), dim3(512), args, LDS_BYTES, stream);
    if (e != hipSuccess) fprintf(stderr, "cooperative launch failed: %s (grid %d)\n", hipGetErrorString(e), grid);
#else
#ifndef PROBE_SEQ
#define PROBE_SEQ 0, 1, 2, 3, 4, 5, 7, 8
#endif
    static const int seq[] = {PROBE_SEQ};
    for (unsigned i = 0; i < sizeof(seq) / sizeof(seq[0]); ++i) { const int k = seq[i]; a.ph_lo = k; a.ph_hi = k + 1; hipLaunchKernelGGL(fwd_kernel, dim3(grid), dim3(512), LDS_BYTES, stream, a); }
#endif
}
```

```cpp
#include <hip/hip_runtime.h>
#include <hip/hip_cooperative_groups.h>
#include <cstdio>
#include <cstdint>
namespace cg = cooperative_groups;

#ifndef MK_NL
#define MK_NL 1
#endif

#define LAS __attribute__((address_space(3)))
typedef unsigned short bf16_t;
typedef short bf16x8 __attribute__((ext_vector_type(8)));
typedef short s16x4 __attribute__((ext_vector_type(4)));
typedef float f32x4 __attribute__((ext_vector_type(4)));
typedef float f32x16 __attribute__((ext_vector_type(16)));
typedef unsigned u32x4 __attribute__((ext_vector_type(4)));
typedef unsigned u32x2 __attribute__((ext_vector_type(2)));

constexpr int NB = 32, SEQ = 2048, DM = 1024, TOK = NB * SEQ;
constexpr int NPROJ = 2304;
constexpr int NQ = 768, NKV = 1024, NFF = 2816, NGU = 2 * NFF;
constexpr int KQ = 384, KKV = 256;
constexpr float EPS = 1e-6f, LOG2E = 1.4426950408889634f;
constexpr float QS_DIFF = 0.125f * LOG2E;
constexpr float QS_MLA = 0.07216878364870322f * LOG2E;
constexpr float LAMBDA_INIT = 0.2f;

constexpr size_t MiB = 1u << 20;
constexpr size_t WS_WIN = 1 * MiB, WS_WQ = 6 * MiB, WS_WKV = 7 * MiB, WS_WOUT = 8 * MiB, WS_WGU = 10 * MiB, WS_WDN = 21 * MiB;
constexpr size_t WS_MOD = 27 * MiB, WS_CS = 28 * MiB, WS_SS = 29 * MiB, WS_SS2 = 34 * MiB;
constexpr size_t WS_XN = 64 * MiB, WS_PROJ = 192 * MiB, WS_Q = 480 * MiB, WS_KV = 576 * MiB, WS_MRG = 704 * MiB, WS_ACT = 192 * MiB, WS_END = 832 * MiB;

constexpr int RING_BYTES = 131072, LDS_BYTES = 147456;

__device__ __forceinline__ unsigned cvt_pk_bf16(float lo, float hi) { unsigned r; asm volatile("v_cvt_pk_bf16_f32 %0, %1, %2" : "=v"(r) : "v"(lo), "v"(hi)); return r; }
__device__ __forceinline__ unsigned f2bf(float f) { unsigned u = __builtin_bit_cast(unsigned, f); return (u + 0x7fffu + ((u >> 16) & 1u)) >> 16; }
__device__ __forceinline__ unsigned pk2(float lo, float hi) { return f2bf(lo) | (f2bf(hi) << 16); }
__device__ __forceinline__ u32x4 pack8(const f32x4 v0, const f32x4 v1) { u32x4 w; w.x = cvt_pk_bf16(v0[0], v0[1]); w.y = cvt_pk_bf16(v0[2], v0[3]); w.z = cvt_pk_bf16(v1[0], v1[1]); w.w = cvt_pk_bf16(v1[2], v1[3]); return w; }
__device__ __forceinline__ float wave_sum(float v) {
#pragma unroll
    for (int o = 1; o < 64; o <<= 1) v += __shfl_xor(v, o);
    return v;
}

namespace pg8 {
constexpr int BM = 256, BK = 64, HALF = 128, HTB = HALF * BK * 2, STAGE_BYTES = 8 * HTB, NXCD = 8, WGM = 8;
__host__ __device__ __forceinline__ int lds_byte(int r, int c) { const int st = (r >> 4) * 2 + (c >> 5), rr = r & 15, cc = c & 31, ob = rr * 64 + cc * 2; return st * 1024 + (ob ^ (((ob >> 9) & 1) << 5)); }
__host__ __device__ __forceinline__ void stage_rc(int b, int& R, int& C) { const int st = b / 1024, sb = b % 1024, swz = sb ^ (((sb >> 9) & 1) << 5); R = (st >> 1) * 16 + swz / 64; C = (st & 1) * 32 + (swz % 64) / 2; }
__host__ __device__ __forceinline__ int perm32(int rho) { const int n = rho >> 4, i = rho & 15; return 8 * (i >> 2) + 4 * n + (i & 3); }

struct Unit { int pm, pn; };
struct Gemm { const bf16_t* A; const bf16_t* Bt; int M, N, K, lda; };

struct StaticOrder {
    int nM, nN, nwg, G, c;
    __device__ void init(int M, int N, int G_, int c_) { nM = M / BM; nN = N / BM; nwg = nM * nN; G = G_; c = c_; }
    __device__ bool next(int i, Unit& u) const {
        const long L = (long)i * G + c; if (L >= nwg) return false;
        int wgid = (int)L; { const int q = nwg / NXCD, r = nwg % NXCD, xcd = wgid % NXCD, off = wgid / NXCD; wgid = (xcd < r ? xcd * (q + 1) : r * (q + 1) + (xcd - r) * q) + off; }
        const int nig = WGM * nN, gid = wgid / nig, fm = gid * WGM, gsz = (nM - fm) < WGM ? (nM - fm) : WGM;
        u.pm = fm + ((wgid % nig) % gsz); u.pn = (wgid % nig) / gsz; return true;
    }
};

template <class Epi, bool ALIGN_EPI>
__device__ __forceinline__ void gemm_phase(LAS unsigned char* lds, const Gemm g, const StaticOrder& S, Epi& E) {
    const int tid = threadIdx.x, wid = __builtin_amdgcn_readfirstlane(tid >> 6), lane = tid & 63, wr = wid >> 2, wc = wid & 3, fr = lane & 15, fq = lane >> 4;
    const int K = g.K, nt = K / BK, lda = g.lda;
    unsigned voffA[2], voffB[2];
#pragma unroll
    for (int i = 0; i < 2; ++i) { int R, C; stage_rc(tid * 16 + i * 8192, R, C); const int Rb = Epi::PERM ? ((R & ~31) + perm32(R & 31)) : R;
        voffA[i] = (unsigned)(R * lda + C) * 2u; voffB[i] = (unsigned)(Rb * K + C) * 2u; }
    const size_t kstep = (size_t)(BK * 2);
    const size_t hstepA = (size_t)HALF * lda * 2, hstepB = (size_t)HALF * K * 2;
    const size_t tstepA = 2 * hstepA, tstepB = 2 * hstepB;
    const unsigned ldsw = (unsigned)wid * 1024u;
    const int aoff = lds_byte(wr * 64 + fr, fq * 8), boff = lds_byte(wc * 32 + fr, fq * 8);
#define PG8_SA(b, h) (((b) * 2 + (h)) * HTB)
#define PG8_SB(b, h) ((4 + (b) * 2 + (h)) * HTB)
#define PG8_STAGE(bufoff, gbase, voff) do { _Pragma("unroll") for (int _i = 0; _i < 2; ++_i) \
        __builtin_amdgcn_global_load_lds((const unsigned*)((const char*)(gbase) + (voff)[_i]), (LAS unsigned*)(lds + (bufoff) + ldsw + _i * 8192), 16, 0, 0); } while (0)
#define PG8_LDA(dst, b, h) do { _Pragma("unroll") for (int m = 0; m < 4; ++m) _Pragma("unroll") for (int k = 0; k < 2; ++k) dst[m][k] = *(const LAS bf16x8*)(lds + PG8_SA(b, h) + aoff + m * 2048 + k * 1024); } while (0)
#define PG8_LDB(dst, b, h) do { _Pragma("unroll") for (int n = 0; n < 2; ++n) _Pragma("unroll") for (int k = 0; k < 2; ++k) dst[n][k] = *(const LAS bf16x8*)(lds + PG8_SB(b, h) + boff + n * 2048 + k * 1024); } while (0)
#define PG8_MMA(ai, bj, At, Bt) do { __builtin_amdgcn_s_setprio(1); _Pragma("unroll") for (int m = 0; m < 4; ++m) _Pragma("unroll") for (int n = 0; n < 2; ++n) _Pragma("unroll") for (int k = 0; k < 2; ++k) \
        acc[ai][bj][m][n] = __builtin_amdgcn_mfma_f32_16x16x32_bf16(Bt[n][k], At[m][k], acc[ai][bj][m][n], 0, 0, 0); __builtin_amdgcn_s_setprio(0); } while (0)
#define PG8_WAIT_V(n) asm volatile("s_waitcnt vmcnt(" #n ")" ::: "memory")
#define PG8_WAIT_L(n) asm volatile("s_waitcnt lgkmcnt(" #n ")" ::: "memory")
#define PG8_BAR __builtin_amdgcn_s_barrier()
#define PG8_SCHED __builtin_amdgcn_sched_barrier(0)
    Unit cur, nxt; int ui = 0;
    if (!S.next(0, cur)) return;
    f32x4 acc[2][2][4][2];
#pragma unroll
    for (int a = 0; a < 2; ++a)
#pragma unroll
        for (int b = 0; b < 2; ++b)
#pragma unroll
            for (int m = 0; m < 4; ++m)
#pragma unroll
                for (int n = 0; n < 2; ++n) acc[a][b][m][n] = (f32x4){0.f, 0.f, 0.f, 0.f};
    bf16x8 At[4][2], B0[2][2], B1[2][2];
    const char* cA = (const char*)g.A + (size_t)cur.pm * tstepA; const char* cB = (const char*)g.Bt + (size_t)cur.pn * tstepB;
    PG8_STAGE(PG8_SB(0, 0), cB, voffB); PG8_STAGE(PG8_SB(0, 1), cB + hstepB, voffB); PG8_STAGE(PG8_SA(0, 0), cA, voffA); PG8_STAGE(PG8_SA(0, 1), cA + hstepA, voffA);
    if (wr == 1) PG8_BAR;
    PG8_WAIT_V(2); PG8_BAR;
    PG8_STAGE(PG8_SB(1, 0), cB + kstep, voffB); PG8_STAGE(PG8_SA(1, 0), cA + kstep, voffA); PG8_STAGE(PG8_SB(1, 1), cB + hstepB + kstep, voffB);
    PG8_WAIT_V(6); PG8_BAR;
    for (;;) {
        const bool has_next = S.next(ui + 1, nxt);
        const char* nA = has_next ? (const char*)g.A + (size_t)nxt.pm * tstepA : cA; const char* nB = has_next ? (const char*)g.Bt + (size_t)nxt.pn * tstepB : cB;
#pragma unroll 1
        for (int t = 0; t < nt; t += 2) {
            const bool last = (t == nt - 2);
            const char* a1 = cA + (size_t)(t + 1) * kstep;
            const char* a2 = last ? nA : cA + (size_t)(t + 2) * kstep; const char* b2 = last ? nB : cB + (size_t)(t + 2) * kstep;
            const char* a3 = a2 + kstep; const char* b3 = b2 + kstep;
            PG8_LDB(B0, 0, 0); PG8_LDB(B1, 0, 1); PG8_SCHED; PG8_LDA(At, 0, 0); PG8_STAGE(PG8_SA(1, 1), a1 + hstepA, voffA);
            PG8_WAIT_V(8); PG8_WAIT_L(0); PG8_BAR; PG8_MMA(0, 0, At, B0); PG8_MMA(0, 1, At, B1); PG8_BAR; PG8_SCHED;
            PG8_LDA(At, 0, 1); PG8_STAGE(PG8_SB(0, 0), b2, voffB); PG8_STAGE(PG8_SB(0, 1), b2 + hstepB, voffB); PG8_STAGE(PG8_SA(0, 0), a2, voffA);
            PG8_WAIT_V(8); PG8_WAIT_L(0); PG8_BAR; PG8_MMA(1, 0, At, B0); PG8_MMA(1, 1, At, B1); PG8_BAR; PG8_SCHED;
            PG8_LDB(B0, 1, 0); PG8_LDB(B1, 1, 1); PG8_SCHED; PG8_LDA(At, 1, 0); PG8_STAGE(PG8_SA(0, 1), a2 + hstepA, voffA);
            PG8_WAIT_V(8); PG8_WAIT_L(0); PG8_BAR; PG8_MMA(0, 0, At, B0); PG8_MMA(0, 1, At, B1); PG8_BAR; PG8_SCHED;
            PG8_LDA(At, 1, 1); PG8_STAGE(PG8_SB(1, 0), b3, voffB); PG8_STAGE(PG8_SB(1, 1), b3 + hstepB, voffB); PG8_STAGE(PG8_SA(1, 0), a3, voffA);
            PG8_WAIT_V(8); PG8_WAIT_L(0); PG8_BAR; PG8_MMA(1, 0, At, B0); PG8_MMA(1, 1, At, B1); PG8_BAR; PG8_SCHED;
        }
        if constexpr (ALIGN_EPI) { if (wr == 0) PG8_BAR; }
        E(acc, cur, wr, wc, fr, fq);
        if (!has_next) break;
#pragma unroll
        for (int a = 0; a < 2; ++a)
#pragma unroll
            for (int b = 0; b < 2; ++b)
#pragma unroll
                for (int m = 0; m < 4; ++m)
#pragma unroll
                    for (int n = 0; n < 2; ++n) acc[a][b][m][n] = (f32x4){0.f, 0.f, 0.f, 0.f};
        cur = nxt; cA = nA; cB = nB; ++ui;
        if constexpr (ALIGN_EPI) { if (wr == 1) PG8_BAR; }
    }
    PG8_WAIT_V(0);
    if constexpr (!ALIGN_EPI) { if (wr == 0) PG8_BAR; }
    PG8_BAR;
#undef PG8_SA
#undef PG8_SB
#undef PG8_STAGE
#undef PG8_LDA
#undef PG8_LDB
#undef PG8_MMA
#undef PG8_WAIT_V
#undef PG8_WAIT_L
#undef PG8_BAR
#undef PG8_SCHED
}
}

__device__ __forceinline__ void modnorm_rows32(const float* X, bf16_t* O, const float* g, const float* sc, const float* sh, int m0, int lane, int nrows = 32) {
    f32x4 ga[4], hb[4];
#pragma unroll
    for (int j = 0; j < 4; ++j) { const int c = 4 * lane + 256 * j; ga[j] = *(const f32x4*)(g + c) * (*(const f32x4*)(sc + c) + 1.0f); hb[j] = *(const f32x4*)(sh + c); }
#pragma unroll 1
    for (int r0 = 0; r0 < nrows; r0 += 4) {
        f32x4 v[4][4]; float s[4];
#pragma unroll
        for (int i = 0; i < 4; ++i) { const f32x4* xr = (const f32x4*)(X + (size_t)(m0 + r0 + i) * DM) + lane;
#pragma unroll
            for (int j = 0; j < 4; ++j) v[i][j] = xr[64 * j]; }
#pragma unroll
        for (int i = 0; i < 4; ++i) { s[i] = 0.f;
#pragma unroll
            for (int j = 0; j < 4; ++j) s[i] += (v[i][j][0] * v[i][j][0] + v[i][j][1] * v[i][j][1]) + (v[i][j][2] * v[i][j][2] + v[i][j][3] * v[i][j][3]); }
#pragma unroll
        for (int o = 1; o < 64; o <<= 1) {
#pragma unroll
            for (int i = 0; i < 4; ++i) s[i] += __shfl_xor(s[i], o); }
#pragma unroll
        for (int i = 0; i < 4; ++i) { const float rstd = 1.0f / sqrtf(s[i] * (1.0f / DM) + EPS); bf16_t* orow = O + (size_t)(m0 + r0 + i) * DM;
#pragma unroll
            for (int j = 0; j < 4; ++j) { const f32x4 y = v[i][j] * rstd * ga[j] + hb[j];
                u32x2 w; w.x = cvt_pk_bf16(y[0], y[1]); w.y = cvt_pk_bf16(y[2], y[3]);
                *(u32x2*)(orow + 4 * lane + 256 * j) = w; } }
    }
}

__device__ __forceinline__ void finalnorm_rows32(float* X, const float* g, int m0, int lane, int nrows = 32) {
    f32x4 gf[4];
#pragma unroll
    for (int j = 0; j < 4; ++j) gf[j] = *(const f32x4*)(g + 4 * lane + 256 * j);
#pragma unroll 1
    for (int r0 = 0; r0 < nrows; r0 += 4) {
        f32x4 v[4][4]; float s[4];
#pragma unroll
        for (int i = 0; i < 4; ++i) { const f32x4* xr = (const f32x4*)(X + (size_t)(m0 + r0 + i) * DM) + lane;
#pragma unroll
            for (int j = 0; j < 4; ++j) v[i][j] = xr[64 * j]; }
#pragma unroll
        for (int i = 0; i < 4; ++i) { s[i] = 0.f;
#pragma unroll
            for (int j = 0; j < 4; ++j) s[i] += (v[i][j][0] * v[i][j][0] + v[i][j][1] * v[i][j][1]) + (v[i][j][2] * v[i][j][2] + v[i][j][3] * v[i][j][3]); }
#pragma unroll
        for (int o = 1; o < 64; o <<= 1) {
#pragma unroll
            for (int i = 0; i < 4; ++i) s[i] += __shfl_xor(s[i], o); }
#pragma unroll
        for (int i = 0; i < 4; ++i) { const float rstd = 1.0f / sqrtf(s[i] * (1.0f / DM) + EPS); f32x4* xr = (f32x4*)(X + (size_t)(m0 + r0 + i) * DM) + lane;
#pragma unroll
            for (int j = 0; j < 4; ++j) xr[64 * j] = v[i][j] * rstd * gf[j]; }
    }
}
__device__ __forceinline__ void unpack8(const u32x4 w, f32x4& a, f32x4& b) {
    a[0] = __uint_as_float(w.x << 16); a[1] = __uint_as_float(w.x & 0xffff0000u); a[2] = __uint_as_float(w.y << 16); a[3] = __uint_as_float(w.y & 0xffff0000u);
    b[0] = __uint_as_float(w.z << 16); b[1] = __uint_as_float(w.z & 0xffff0000u); b[2] = __uint_as_float(w.w << 16); b[3] = __uint_as_float(w.w & 0xffff0000u);
}
__device__ __forceinline__ float wave_sum4(float (&s)[4]) {
#pragma unroll
    for (int o = 1; o < 64; o <<= 1) {
#pragma unroll
        for (int i = 0; i < 4; ++i) s[i] += __shfl_xor(s[i], o); }
    return 0.f;
}
__device__ __forceinline__ void modnorm_rows_b(const bf16_t* X, bf16_t* O, const float* g, const float* sc, const float* sh, int m0, int lane, int nrows) {
    f32x4 ga[4], hb[4];
#pragma unroll
    for (int j = 0; j < 4; ++j) { const int c = 8 * lane + 512 * (j >> 1) + 4 * (j & 1); ga[j] = *(const f32x4*)(g + c) * (*(const f32x4*)(sc + c) + 1.0f); hb[j] = *(const f32x4*)(sh + c); }
#pragma unroll 1
    for (int r0 = 0; r0 < nrows; r0 += 4) {
        u32x4 w[4][2]; f32x4 v[4][4]; float s[4];
#pragma unroll
        for (int i = 0; i < 4; ++i) { const u32x4* xr = (const u32x4*)(X + (size_t)(m0 + r0 + i) * DM) + lane; w[i][0] = xr[0]; w[i][1] = xr[64]; }
#pragma unroll
        for (int i = 0; i < 4; ++i) { unpack8(w[i][0], v[i][0], v[i][1]); unpack8(w[i][1], v[i][2], v[i][3]); s[i] = 0.f;
#pragma unroll
            for (int j = 0; j < 4; ++j) s[i] += (v[i][j][0] * v[i][j][0] + v[i][j][1] * v[i][j][1]) + (v[i][j][2] * v[i][j][2] + v[i][j][3] * v[i][j][3]); }
        wave_sum4(s);
#pragma unroll
        for (int i = 0; i < 4; ++i) { const float rstd = 1.0f / sqrtf(s[i] * (1.0f / DM) + EPS); u32x4* orow = (u32x4*)(O + (size_t)(m0 + r0 + i) * DM) + lane;
            const f32x4 y0 = v[i][0] * rstd * ga[0] + hb[0], y1 = v[i][1] * rstd * ga[1] + hb[1], y2 = v[i][2] * rstd * ga[2] + hb[2], y3 = v[i][3] * rstd * ga[3] + hb[3];
            orow[0] = pack8(y0, y1); orow[64] = pack8(y2, y3); }
    }
}
__device__ __forceinline__ void finalnorm_rows_b(const bf16_t* X, float* OUT, const float* g, int m0, int lane, int nrows) {
    f32x4 gf[4];
#pragma unroll
    for (int j = 0; j < 4; ++j) gf[j] = *(const f32x4*)(g + 8 * lane + 512 * (j >> 1) + 4 * (j & 1));
#pragma unroll 1
    for (int r0 = 0; r0 < nrows; r0 += 4) {
        u32x4 w[4][2]; f32x4 v[4][4]; float s[4];
#pragma unroll
        for (int i = 0; i < 4; ++i) { const u32x4* xr = (const u32x4*)(X + (size_t)(m0 + r0 + i) * DM) + lane; w[i][0] = xr[0]; w[i][1] = xr[64]; }
#pragma unroll
        for (int i = 0; i < 4; ++i) { unpack8(w[i][0], v[i][0], v[i][1]); unpack8(w[i][1], v[i][2], v[i][3]); s[i] = 0.f;
#pragma unroll
            for (int j = 0; j < 4; ++j) s[i] += (v[i][j][0] * v[i][j][0] + v[i][j][1] * v[i][j][1]) + (v[i][j][2] * v[i][j][2] + v[i][j][3] * v[i][j][3]); }
        wave_sum4(s);
#pragma unroll
        for (int i = 0; i < 4; ++i) { const float rstd = 1.0f / sqrtf(s[i] * (1.0f / DM) + EPS); f32x4* orow = (f32x4*)(OUT + (size_t)(m0 + r0 + i) * DM) + 2 * lane;
            orow[0] = v[i][0] * rstd * gf[0]; orow[1] = v[i][1] * rstd * gf[1]; orow[128] = v[i][2] * rstd * gf[2]; orow[129] = v[i][3] * rstd * gf[3]; }
    }
}

__device__ __forceinline__ bool panel_arrive_last(unsigned* cnt, int pm, unsigned ntiles, LAS unsigned char* lds) {
    asm volatile("s_waitcnt vmcnt(0)" ::: "memory");
    __syncthreads();
    LAS unsigned* flag = (LAS unsigned*)(lds + RING_BYTES + 64);
    if (threadIdx.x == 0) {
        const unsigned old = __hip_atomic_fetch_add(cnt + pm, 1u, __ATOMIC_RELAXED, __HIP_MEMORY_SCOPE_AGENT);
        const bool last = (old == ntiles - 1u);
        if (last) { __builtin_amdgcn_fence(__ATOMIC_ACQUIRE, "agent"); asm volatile("s_waitcnt vmcnt(0)" ::: "memory"); }
        *flag = last ? 1u : 0u;
    }
    __syncthreads();
    return *flag != 0u;
}

typedef const f32x4 (&AccRef)[2][2][4][2];

__device__ __forceinline__ void rope8(f32x4& v0, f32x4& v1, const float* cs, int t, int i0) {
    const f32x4 a = *(const f32x4*)(cs + ((size_t)t * 32 + i0) * 2), b = *(const f32x4*)(cs + ((size_t)t * 32 + i0 + 2) * 2);
    f32x4 o0, o1;
    o0[0] = v0[0] * a[0] - v0[1] * a[1]; o0[1] = v0[0] * a[1] + v0[1] * a[0];
    o0[2] = v0[2] * a[2] - v0[3] * a[3]; o0[3] = v0[2] * a[3] + v0[3] * a[2];
    o1[0] = v1[0] * b[0] - v1[1] * b[1]; o1[1] = v1[0] * b[1] + v1[1] * b[0];
    o1[2] = v1[2] * b[2] - v1[3] * b[3]; o1[3] = v1[2] * b[3] + v1[3] * b[2];
    v0 = o0; v1 = o1;
}

struct EpiInProj {
    static constexpr bool PERM = true;
    bf16_t* O; float* SS; const float* cs;
    __device__ __forceinline__ void operator()(AccRef acc, const pg8::Unit& u, int wr, int wc, int fr, int fq) const {
        const int row0 = u.pm * 256 + wr * 64 + fr, colt = u.pn * 256;
#pragma unroll
        for (int ai = 0; ai < 2; ++ai)
#pragma unroll
            for (int m = 0; m < 4; ++m) { const int row = row0 + ai * 128 + m * 16;
#pragma unroll
                for (int bj = 0; bj < 2; ++bj) {
                    f32x4 v0 = acc[ai][bj][m][0], v1 = acc[ai][bj][m][1];
                    const int slab = (colt + bj * 128 + wc * 32) >> 5;
                    if (slab >= 48 && slab < 68) {
                        float ss = (v0[0] * v0[0] + v0[1] * v0[1]) + (v0[2] * v0[2] + v0[3] * v0[3]) + (v1[0] * v1[0] + v1[1] * v1[1]) + (v1[2] * v1[2] + v1[3] * v1[3]);
                        ss += __shfl_xor(ss, 16); ss += __shfl_xor(ss, 32);
                        if (fq == 0) SS[(size_t)row * 20 + (slab - 48)] = ss;
                    }
                    if (slab < 16) { v0 = v0 * QS_DIFF; v1 = v1 * QS_DIFF; }
                    if (slab == 68 || slab == 69) rope8(v0, v1, cs, row & (SEQ - 1), (slab - 68) * 16 + fq * 4);
                    *(u32x4*)(O + (size_t)row * NPROJ + colt + bj * 128 + wc * 32 + 8 * fq) = pack8(v0, v1);
                } }
    }
};
struct EpiQUp {
    static constexpr bool PERM = true;
    bf16_t* O; const float* SS; const float* cs;
    __device__ __forceinline__ void operator()(AccRef acc, const pg8::Unit& u, int wr, int wc, int fr, int fq) const {
        const int row0 = u.pm * 256 + wr * 64 + fr, colt = u.pn * 256;
        float scl[2];
#pragma unroll
        for (int ai = 0; ai < 2; ++ai) { const float* sp = SS + (size_t)(u.pm * 256 + wr * 64 + ai * 128 + fq * 16 + fr) * 20;
            const f32x4 s0 = *(const f32x4*)(sp), s1 = *(const f32x4*)(sp + 4), s2 = *(const f32x4*)(sp + 8);
            const float ss = ((s0[0] + s0[1]) + (s0[2] + s0[3])) + ((s1[0] + s1[1]) + (s1[2] + s1[3])) + ((s2[0] + s2[1]) + (s2[2] + s2[3]));
            scl[ai] = QS_MLA / sqrtf(ss * (1.0f / KQ) + EPS); }
#pragma unroll
        for (int ai = 0; ai < 2; ++ai)
#pragma unroll
            for (int m = 0; m < 4; ++m) { const int row = row0 + ai * 128 + m * 16;
                const float sc = __shfl(scl[ai], m * 16 + fr);
#pragma unroll
                for (int bj = 0; bj < 2; ++bj) {
                    f32x4 v0 = acc[ai][bj][m][0] * sc, v1 = acc[ai][bj][m][1] * sc;
                    const int c0 = colt + bj * 128 + wc * 32 + 8 * fq, head = c0 / 192, within = c0 - head * 192;
                    if (within >= 128) rope8(v0, v1, cs, row & (SEQ - 1), (within - 128) >> 1);
                    *(u32x4*)(O + (size_t)row * NQ + c0) = pack8(v0, v1);
                } }
    }
};
struct EpiKvUp {
    static constexpr bool PERM = true;
    bf16_t* O; const float* SS;
    __device__ __forceinline__ void operator()(AccRef acc, const pg8::Unit& u, int wr, int wc, int fr, int fq) const {
        const int row0 = u.pm * 256 + wr * 64 + fr, colt = u.pn * 256;
        float scl[2];
#pragma unroll
        for (int ai = 0; ai < 2; ++ai) { const float* sp = SS + (size_t)(u.pm * 256 + wr * 64 + ai * 128 + fq * 16 + fr) * 20 + 12;
            const f32x4 s0 = *(const f32x4*)(sp), s1 = *(const f32x4*)(sp + 4);
            const float ss = ((s0[0] + s0[1]) + (s0[2] + s0[3])) + ((s1[0] + s1[1]) + (s1[2] + s1[3]));
            scl[ai] = 1.0f / sqrtf(ss * (1.0f / KKV) + EPS); }
#pragma unroll
        for (int ai = 0; ai < 2; ++ai)
#pragma unroll
            for (int m = 0; m < 4; ++m) { const int row = row0 + ai * 128 + m * 16;
                const float sc = __shfl(scl[ai], m * 16 + fr);
#pragma unroll
                for (int bj = 0; bj < 2; ++bj) {
                    const f32x4 v0 = acc[ai][bj][m][0] * sc, v1 = acc[ai][bj][m][1] * sc;
                    *(u32x4*)(O + (size_t)row * NKV + colt + bj * 128 + wc * 32 + 8 * fq) = pack8(v0, v1);
                } }
    }
};
__device__ __forceinline__ void panel_step(unsigned* cnt, int pmAnn, int pmWait) {
    asm volatile("s_waitcnt vmcnt(0)" ::: "memory");
    __syncthreads();
    if (threadIdx.x == 0) {
        if (pmAnn >= 0) (void)__hip_atomic_fetch_add(cnt + pmAnn, 1u, __ATOMIC_RELAXED, __HIP_MEMORY_SCOPE_AGENT);
        if (pmWait >= 0) { unsigned spins = 0;
            while (__hip_atomic_load(cnt + pmWait, __ATOMIC_RELAXED, __HIP_MEMORY_SCOPE_AGENT) < 4u) { __builtin_amdgcn_s_sleep(2); if (++spins > (1u << 16)) break; }
            __builtin_amdgcn_fence(__ATOMIC_ACQUIRE, "agent"); asm volatile("s_waitcnt vmcnt(0)" ::: "memory"); }
    }
    __syncthreads();
}
template <int MODE> struct EpiResGate {
    static constexpr bool PERM = true;
    const float* basef; const bf16_t* baseb; bf16_t* tile; const float* gate; unsigned* cnt; LAS unsigned char* lds; bf16_t* XN; float* OUT; const float* gn; const float* MODp;
    int pmA, pnA, pmB, pnB;
    __device__ __forceinline__ void rows(int pm, int pn, int nrq) const {
        const int lane = threadIdx.x & 63, wv = threadIdx.x >> 6, m0 = pm * 256 + pn * 64 + wv * nrq;
        if (MODE == 0) { const float* mb = MODp + (size_t)(m0 >> 11) * 6144; modnorm_rows_b(tile, XN, gn, mb + 4096, mb + 3072, m0, lane, nrq); }
        else finalnorm_rows_b(tile, OUT, gn, m0, lane, nrq);
    }
    __device__ __forceinline__ void operator()(AccRef acc, const pg8::Unit& u, int wr, int wc, int fr, int fq) {
        const bool fast = (gridDim.x == 256);
        int nbm = -1, nbn = 0;
        if (fast) { if (pmA >= 0) { panel_step(cnt, pmA, pmB); nbm = pmB; nbn = pnB; } pmB = pmA; pnB = pnA; }
        const int row0 = u.pm * 256 + wr * 64 + fr, colt = u.pn * 256;
        const float* gb = gate + (size_t)((u.pm * 256) >> 11) * 6144;
        const __amdgpu_buffer_rsrc_t rs = __builtin_amdgcn_make_buffer_rsrc((void*)tile, 0, TOK * DM * 2, 0x00020000);
#pragma unroll
        for (int bj = 0; bj < 2; ++bj) {
            const int c0 = colt + bj * 128 + wc * 32 + 8 * fq;
            const f32x4 g0 = *(const f32x4*)(gb + c0), g1 = *(const f32x4*)(gb + c0 + 4);
#pragma unroll
            for (int ai = 0; ai < 2; ++ai)
#pragma unroll
                for (int m = 0; m < 4; ++m) { const int row = row0 + ai * 128 + m * 16; const size_t off = (size_t)row * DM + c0;
                    f32x4 b0, b1;
                    if (MODE == 0) { b0 = *(const f32x4*)(basef + off); b1 = *(const f32x4*)(basef + off + 4); }
                    else unpack8(*(const u32x4*)(baseb + off), b0, b1);
                    const f32x4 o0 = b0 + g0 * acc[ai][bj][m][0], o1 = b1 + g1 * acc[ai][bj][m][1];
                    __builtin_amdgcn_raw_buffer_store_b128(pack8(o0, o1), rs, (unsigned)(off * 2), 0, 16); }
        }
        pmA = u.pm; pnA = u.pn;
        if (fast) { if (nbm >= 0) rows(nbm, nbn, 8); }
        else { const bool last = panel_arrive_last(cnt, u.pm, 4u, lds); rows(u.pm, 0, last ? 32 : 0); }
    }
    __device__ __forceinline__ void finish() {
        if (gridDim.x != 256) return;
        panel_step(cnt, pmA, pmB); if (pmB >= 0) rows(pmB, pnB, 8);
        panel_step(cnt, -1, pmA); if (pmA >= 0) rows(pmA, pnA, 8);
    }
};
struct EpiSwiGLU {
    static constexpr bool PERM = true;
    bf16_t* O;
    __device__ __forceinline__ void operator()(AccRef acc, const pg8::Unit& u, int wr, int wc, int fr, int fq) const {
        const int row0 = u.pm * 256 + wr * 64 + fr, c0 = u.pn * 128 + wc * 32 + 8 * fq;
#pragma unroll
        for (int ai = 0; ai < 2; ++ai)
#pragma unroll
            for (int m = 0; m < 4; ++m) { const int row = row0 + ai * 128 + m * 16;
                f32x4 r[2];
#pragma unroll
                for (int n = 0; n < 2; ++n) { const f32x4 gt = acc[ai][0][m][n], up = acc[ai][1][m][n];
#pragma unroll
                    for (int e = 0; e < 4; ++e) { const float sg = __builtin_amdgcn_rcpf(1.0f + __builtin_amdgcn_exp2f(-gt[e] * LOG2E)); r[n][e] = gt[e] * sg * up[e]; } }
                *(u32x4*)(O + (size_t)row * NFF + c0) = pack8(r[0], r[1]);
            }
    }
};

struct Args {
    const float *x, *c, *w_ada, *b_ada, *g_mix, *w_in, *lq1, *lk1, *lq2, *lk2, *g_diff_out, *g_q_lat, *w_q_up, *g_kv_lat, *w_kv_up, *w_out, *g_ffn, *w_gate, *w_up, *w_down, *g_final;
    float* out; unsigned char* ws; int ph_lo, ph_hi;
};

__device__ __forceinline__ int src_col(int mode, int n) {
    if (mode == 0) { if (n < 2176) return n; if (n >= 2240) return -1; const int j = n - 2176; return 2176 + (j >> 1) + 32 * (j & 1); }
    if (mode == 1) { const int head = n / 192, w = n - head * 192; if (w < 128) return n; const int j = w - 128; return head * 192 + 128 + (j >> 1) + 32 * (j & 1); }
    if (mode == 3) { return (n >> 8) * 128 + (n & 127); }
    return n;
}
__device__ __forceinline__ void transpose_item(const float* W, const float* W2, int K, int Nsrc, bf16_t* WT, int mode, const float* gain, LAS float* scr, int item, int nblk, int lane) {
    const int kb = item / nblk, nb = item % nblk, k0 = 64 * kb, n0 = 32 * nb;
    const int nn = n0 + (lane & 31), sc = src_col(mode, nn);
    const float* Wp = (mode == 3 && ((nn >> 7) & 1)) ? W2 : W;
#pragma unroll 16
    for (int i = 0; i < 32; ++i) { const int kk = 2 * i + (lane >> 5); float v = (sc >= 0) ? Wp[(size_t)(k0 + kk) * Nsrc + sc] : 0.f; if (gain) v *= gain[k0 + kk]; scr[kk * 33 + (lane & 31)] = v; }
    asm volatile("s_waitcnt lgkmcnt(0)" ::: "memory");
    const int c = lane & 7;
#pragma unroll
    for (int j = 0; j < 4; ++j) { const int n = (lane >> 3) + 8 * j; const LAS float* s = scr + (8 * c) * 33 + n;
        u32x4 o; o.x = pk2(s[0 * 33], s[1 * 33]); o.y = pk2(s[2 * 33], s[3 * 33]); o.z = pk2(s[4 * 33], s[5 * 33]); o.w = pk2(s[6 * 33], s[7 * 33]);
        *(u32x4*)(WT + (size_t)(n0 + n) * K + k0 + 8 * c) = o; }
    asm volatile("s_waitcnt lgkmcnt(0)" ::: "memory");
}
__device__ __forceinline__ void adaln_item(const Args& a, float* MOD, LAS unsigned char* lds, int item) {
    LAS float* L = (LAS float*)lds;
    const int tid = threadIdx.x, lane = tid & 63, wid = tid >> 6, j0 = item * 64;
#pragma unroll 16
    for (int i = 0; i < 64; ++i) { const int idx = tid + 512 * i, b = idx >> 10, k = idx & 1023; const float v = a.c[idx]; L[k * 32 + (b ^ ((k & 7) << 2))] = v / (1.0f + __expf(-v)); }
    __syncthreads();
    float acc[32];
#pragma unroll
    for (int b = 0; b < 32; ++b) acc[b] = 0.f;
#pragma unroll 16
    for (int kk = 0; kk < 128; ++kk) { const int k = wid * 128 + kk; const float wv = a.w_ada[(size_t)k * 6144 + j0 + lane];
#pragma unroll
        for (int b4 = 0; b4 < 8; ++b4) { const f32x4 cv = *(const LAS f32x4*)(L + k * 32 + 4 * (b4 ^ (kk & 7)));
            acc[4 * b4 + 0] += wv * cv[0]; acc[4 * b4 + 1] += wv * cv[1]; acc[4 * b4 + 2] += wv * cv[2]; acc[4 * b4 + 3] += wv * cv[3]; } }
    __syncthreads();
#pragma unroll
    for (int b = 0; b < 32; ++b) L[(wid * 32 + b) * 64 + lane] = acc[b];
    __syncthreads();
#pragma unroll
    for (int i = 0; i < 4; ++i) { const int o = tid + 512 * i, b = o >> 6, col = o & 63; float s = a.b_ada[j0 + col];
#pragma unroll
        for (int w = 0; w < 8; ++w) s += L[(w * 32 + b) * 64 + col];
        MOD[(size_t)b * 6144 + j0 + col] = s; }
    __syncthreads();
}
__device__ __forceinline__ s16x4 vtr(const LAS unsigned char* p) { return __builtin_bit_cast(s16x4, __builtin_amdgcn_ds_read_tr16_b64_v4i16((LAS s16x4*)p)); }

template <bool DIFF>
__device__ __forceinline__ void attn_unit(LAS unsigned char* lds, const bf16_t* PROJ, const bf16_t* QBUF, const bf16_t* KVB, bf16_t* MRG, const float* gdo, float lam, int b, int h, int qb) {
    constexpr int DQK = DIFF ? 64 : 192, NDS = DQK / 16, QB = DIFF ? 128 : 256;
    constexpr int POFF = 16384, VOFF = DIFF ? 16384 : 24576, STAGE = VOFF + 16384;
    constexpr float THR = 8.0f;
    const int tid = threadIdx.x, lane = tid & 63, r32 = lane & 31, hi = lane >> 5, wid = __builtin_amdgcn_readfirstlane(tid >> 6);
    const int map = DIFF ? (wid >> 2) : 0, wq = DIFF ? (wid & 3) : wid;
    const int q0 = qb * QB, qw0 = q0 + 32 * wq, qpos = qw0 + r32;
    const size_t rowbase = (size_t)b * SEQ;
    const int NT = (q0 + QB) / 64, tw = qw0 >> 6;
    bf16x8 qf[NDS];
    { const bf16_t* qp = DIFF ? PROJ + (rowbase + qpos) * NPROJ + h * 128 + map * 64 : QBUF + (rowbase + qpos) * NQ + h * 192;
#pragma unroll
      for (int ds = 0; ds < NDS; ++ds) qf[ds] = *(const bf16x8*)(qp + ds * 16 + hi * 8); }
    u32x4 qaug = (u32x4){0u, 0u, 0u, 0u}, kaug0 = qaug, kaug1 = qaug;
    if (DIFF) {
        const float c1 = LOG2E / (float)(1 << (2 * (h + 1))), c64 = 64.f * c1;
        const unsigned c1h = f2bf(c1), c1l = f2bf(c1 - __uint_as_float(c1h << 16)), c6h = f2bf(c64), c6l = f2bf(c64 - __uint_as_float(c6h << 16));
        const unsigned j0 = __float_as_uint((float)r32) >> 16, j1 = __float_as_uint((float)(r32 + 32)) >> 16;
        if (hi == 0) { qaug.x = c1h | (c1l << 16); qaug.y = c6h | (c6l << 16); kaug0.x = j0 | (j0 << 16); kaug1.x = j1 | (j1 << 16); }
    }
    f32x16 o[4];
#pragma unroll
    for (int d0 = 0; d0 < 4; ++d0)
#pragma unroll
        for (int r = 0; r < 16; ++r) o[d0][r] = 0.f;
    f32x16 negm;
#pragma unroll
    for (int r = 0; r < 16; ++r) negm[r] = 0.f;
    float mrun = 0.f, lrun = 0.f;
    constexpr size_t PITCH = DIFF ? NPROJ : NKV;
    const int Lrr = (lane >> 2) & 7, Lsub = lane >> 5, Lslot = lane & 3;
    const int xr = (2 * ((wid >> 1) & 1) + (Lrr >> 2)) & 3, xp = (2 * (wid & 1) + (Lrr >> 2)) & 3;
    const int rowA = 8 * (wid >> 1) + Lrr, chA = 4 * (2 * (wid & 1) + Lsub) + (Lslot ^ xr);
    const bf16_t* gK = (DIFF ? PROJ + (rowbase + rowA) * NPROJ + 512 + h * 128 : KVB + (rowbase + rowA) * NKV + h * 256) + chA * 8;
    const bf16_t* gV = (DIFF ? PROJ + (rowbase + rowA) * NPROJ + 1024 + h * 128 : KVB + (rowbase + rowA) * NKV + h * 256 + 128) + chA * 8;
    const bf16_t* gP = PROJ + (rowbase + 8 * wid + Lrr) * NPROJ + 2176 + (4 * Lsub + (Lslot ^ xp)) * 8;
    const int dW = wid * 1024;
#define ATT_DMA(src, dst) __builtin_amdgcn_global_load_lds((const unsigned*)(src), (LAS unsigned*)(dst), 16, 0, 0)
#define ATT_LOAD(t, st) do { const size_t ro_ = (size_t)(t) * 64 * PITCH; LAS unsigned char* sb_ = lds + (st) * STAGE + dW; \
        ATT_DMA(gK + ro_, sb_); ATT_DMA(gK + ro_ + 32 * PITCH, sb_ + 8192); \
        ATT_DMA(gV + ro_, sb_ + VOFF); ATT_DMA(gV + ro_ + 32 * PITCH, sb_ + VOFF + 8192); \
        if (!DIFF) ATT_DMA(gP + (size_t)(t) * 64 * NPROJ, sb_ + POFF); } while (0)
#define ATT_BAR() do { asm volatile("" ::: "memory"); __builtin_amdgcn_s_barrier(); asm volatile("" ::: "memory"); } while (0)
#define SB() __builtin_amdgcn_sched_barrier(0)
    const int xq = (r32 >> 2) & 3;
    const int kb0 = 2048 * (r32 >> 3) + 64 * (r32 & 7) + 1024 * map + 16 * (hi ^ xq), kb1 = kb0 ^ 32;
    const int pb0 = POFF + 1024 * (r32 >> 3) + 64 * (r32 & 7) + 16 * (hi ^ xq), pb1 = pb0 ^ 32;
    const int vq = (lane & 15) >> 2, vp = lane & 3;
    const int vb0 = VOFF + 64 * (4 * hi + vq) + 16 * ((2 * ((lane >> 4) & 1)) | ((vp >> 1) ^ hi)) + 8 * (vp & 1), vb1 = vb0 ^ 32;
#define KFR(ds, hh) (*(const LAS bf16x8*)(sb + (((ds) & 1) ? kb1 : kb0) + 8192 * (hh) + 512 * ((ds) >> 1)))
#define PFR(dp, hh) (*(const LAS bf16x8*)(sb + (((dp) & 1) ? pb1 : pb0) + 4096 * (hh) + 512 * ((dp) >> 1)))
#define KMLA(ds, hh) ((ds) < 8 ? KFR(ds, hh) : PFR((ds) - 8, hh))
#define VTR(dst, addr, off) asm volatile("ds_read_b64_tr_b16 %0, %1 offset:%2" : "=v"(dst) : "v"(addr), "i"(off) : "memory")
    asm volatile("s_waitcnt lgkmcnt(0)" ::: "memory");
    ATT_BAR();
    ATT_LOAD(NT - 1, 0);
    if (NT > 1) ATT_LOAD(NT - 2, 1);
    bool first = true;
    int st = 0, st2 = 2;
    for (int it = 0; it < NT; ++it) {
        const int t = NT - 1 - it;
        if (it + 1 < NT) { if (DIFF) asm volatile("s_waitcnt vmcnt(4)" ::: "memory"); else asm volatile("s_waitcnt vmcnt(5)" ::: "memory"); }
        else asm volatile("s_waitcnt vmcnt(0)" ::: "memory");
        ATT_BAR();
        if (it + 2 < NT) ATT_LOAD(t - 2, st2);
        if (t <= tw) {
            const LAS unsigned char* sb = lds + st * STAGE;
            f32x16 s0, s1;
            if (DIFF) {
                bf16x8 kf[8];
#pragma unroll
                for (int i = 0; i < 4; ++i) { kf[2 * i] = KFR(i, 0); kf[2 * i + 1] = KFR(i, 1); }
                SB();
                const unsigned tb = __float_as_uint((float)t) >> 16;
                if (hi == 0) { kaug0.y = tb | (tb << 16); kaug1.y = kaug0.y; }
                __builtin_amdgcn_s_setprio(1);
                s0 = __builtin_amdgcn_mfma_f32_32x32x16_bf16(__builtin_bit_cast(bf16x8, kaug0), __builtin_bit_cast(bf16x8, qaug), negm, 0, 0, 0);
                s1 = __builtin_amdgcn_mfma_f32_32x32x16_bf16(__builtin_bit_cast(bf16x8, kaug1), __builtin_bit_cast(bf16x8, qaug), negm, 0, 0, 0);
#pragma unroll
                for (int ds = 0; ds < 4; ++ds) {
                    s0 = __builtin_amdgcn_mfma_f32_32x32x16_bf16(kf[2 * ds], qf[ds], s0, 0, 0, 0);
                    s1 = __builtin_amdgcn_mfma_f32_32x32x16_bf16(kf[2 * ds + 1], qf[ds], s1, 0, 0, 0);
                }
                __builtin_amdgcn_s_setprio(0);
            } else {
                bf16x8 kf[4];
#pragma unroll
                for (int i = 0; i < 2; ++i) { kf[2 * i] = KFR(i, 0); kf[2 * i + 1] = KFR(i, 1); }
#pragma unroll
                for (int g = 0; g < 6; ++g) {
                    bf16x8 kn[4];
                    if (g < 5) {
#pragma unroll
                        for (int i = 0; i < 2; ++i) { kn[2 * i] = KMLA(2 * g + 2 + i, 0); kn[2 * i + 1] = KMLA(2 * g + 2 + i, 1); }
                    }
                    SB();
                    __builtin_amdgcn_s_setprio(1);
                    if (g == 0) { s0 = __builtin_amdgcn_mfma_f32_32x32x16_bf16(kf[0], qf[0], negm, 0, 0, 0); s1 = __builtin_amdgcn_mfma_f32_32x32x16_bf16(kf[1], qf[0], negm, 0, 0, 0); }
                    else { s0 = __builtin_amdgcn_mfma_f32_32x32x16_bf16(kf[0], qf[2 * g], s0, 0, 0, 0); s1 = __builtin_amdgcn_mfma_f32_32x32x16_bf16(kf[1], qf[2 * g], s1, 0, 0, 0); }
                    s0 = __builtin_amdgcn_mfma_f32_32x32x16_bf16(kf[2], qf[2 * g + 1], s0, 0, 0, 0); s1 = __builtin_amdgcn_mfma_f32_32x32x16_bf16(kf[3], qf[2 * g + 1], s1, 0, 0, 0);
                    __builtin_amdgcn_s_setprio(0);
                    SB();
                    if (g < 5) {
#pragma unroll
                        for (int i = 0; i < 4; ++i) kf[i] = kn[i];
                    }
                }
            }
            s16x4 vl[4][4], vh[4][4];
            const unsigned va0 = (unsigned)(uintptr_t)(sb + vb0), va1 = (unsigned)(uintptr_t)(sb + vb1);
#pragma unroll
            for (int s = 0; s < 2; ++s)
#pragma unroll
                for (int d0 = 0; d0 < 4; ++d0) { VTR(vl[s][d0], va0, s * 4096 + d0 * 512); VTR(vh[s][d0], va1, s * 4096 + 2048 + d0 * 512); }
            SB();
            if (t == tw) {
                const int kvl = 64 * t + 4 * hi - qpos;
#pragma unroll
                for (int r = 0; r < 16; ++r) { const int cr = (r & 3) + 8 * (r >> 2); if (kvl + cr > 0) s0[r] = -1e30f; if (kvl + cr + 32 > 0) s1[r] = -1e30f; }
            }
            float mx = fmaxf(s0[0], s1[0]);
#pragma unroll
            for (int r = 1; r < 16; ++r) mx = fmaxf(fmaxf(mx, s0[r]), s1[r]);
            mx = fmaxf(mx, __shfl_xor(mx, 32));
            if (first || __any(mx > THR)) {
                const float dl = first ? mx : fmaxf(mx, 0.f);
                mrun += dl;
#pragma unroll
                for (int r = 0; r < 16; ++r) { s0[r] -= dl; s1[r] -= dl; negm[r] = -mrun; }
                asm volatile("" : "+v"(negm));
                if (!first) { const float f = __builtin_amdgcn_exp2f(-dl); lrun *= f;
#pragma unroll
                    for (int d0 = 0; d0 < 4; ++d0)
#pragma unroll
                        for (int r = 0; r < 16; ++r) o[d0][r] *= f; }
                first = false;
            }
            float ls = 0.f;
#pragma unroll
            for (int r = 0; r < 16; ++r) { s0[r] = __builtin_amdgcn_exp2f(s0[r]); s1[r] = __builtin_amdgcn_exp2f(s1[r]); ls += s0[r]; ls += s1[r]; }
            lrun += ls;
            u32x4 pw[4];
#pragma unroll
            for (int j = 0; j < 4; ++j) { pw[0][j] = cvt_pk_bf16(s0[2 * j], s0[2 * j + 1]); pw[1][j] = cvt_pk_bf16(s0[8 + 2 * j], s0[8 + 2 * j + 1]);
                                          pw[2][j] = cvt_pk_bf16(s1[2 * j], s1[2 * j + 1]); pw[3][j] = cvt_pk_bf16(s1[8 + 2 * j], s1[8 + 2 * j + 1]); }
            asm volatile("s_waitcnt lgkmcnt(0)" ::: "memory");
#pragma unroll
            for (int s = 2; s < 4; ++s)
#pragma unroll
                for (int d0 = 0; d0 < 4; ++d0) { VTR(vl[s][d0], va0, s * 4096 + d0 * 512); VTR(vh[s][d0], va1, s * 4096 + 2048 + d0 * 512); }
            SB();
#pragma unroll
            for (int s = 0; s < 4; ++s) {
                if (s == 2) { asm volatile("s_waitcnt lgkmcnt(0)" ::: "memory"); SB(); }
                __builtin_amdgcn_s_setprio(1);
#pragma unroll
                for (int d0 = 0; d0 < 4; ++d0) {
                    const bf16x8 vf = __builtin_shufflevector(vl[s][d0], vh[s][d0], 0, 1, 2, 3, 4, 5, 6, 7);
                    o[d0] = __builtin_amdgcn_mfma_f32_32x32x16_bf16(vf, __builtin_bit_cast(bf16x8, pw[s]), o[d0], 0, 0, 0);
                }
                __builtin_amdgcn_s_setprio(0);
            }
            SB();
        }
        st = (st == 2) ? 0 : st + 1; st2 = (st2 == 2) ? 0 : st2 + 1;
    }
    asm volatile("s_waitcnt lgkmcnt(0)" ::: "memory");
    ATT_BAR();
#undef ATT_DMA
#undef ATT_LOAD
#undef SB
#undef KFR
#undef PFR
#undef KMLA
#undef VTR
    const float inv = 1.0f / (lrun + __shfl_xor(lrun, 32));
    if (DIFF) {
        LAS float* X = (LAS float*)lds + (size_t)(wq * 64) * 64 + lane;
        if (map == 1) {
#pragma unroll
            for (int d0 = 0; d0 < 4; ++d0)
#pragma unroll
                for (int r = 0; r < 16; ++r) X[(d0 * 16 + r) * 64] = o[d0][r] * inv;
        }
        asm volatile("s_waitcnt lgkmcnt(0)" ::: "memory");
        ATT_BAR();
        if (map == 0) {
            float ss = 0.f;
#pragma unroll
            for (int d0 = 0; d0 < 4; ++d0)
#pragma unroll
                for (int r = 0; r < 16; ++r) { const float v = o[d0][r] * inv - lam * X[(d0 * 16 + r) * 64]; o[d0][r] = v; ss += v * v; }
            ss += __shfl_xor(ss, 32);
            const float rs = (1.0f - LAMBDA_INIT) / sqrtf(ss * (1.0f / 128.f) + EPS);
            bf16_t* op = MRG + (rowbase + qpos) * DM + h * 128;
#pragma unroll
            for (int d0 = 0; d0 < 4; ++d0)
#pragma unroll
                for (int gp = 0; gp < 2; ++gp) {
                    u32x2 w[2];
#pragma unroll
                    for (int k = 0; k < 2; ++k) { const int g = 2 * gp + k, d = 32 * d0 + 8 * g + 4 * hi; const f32x4 gg = *(const f32x4*)(gdo + d);
                        w[k].x = cvt_pk_bf16(o[d0][4 * g] * rs * gg[0], o[d0][4 * g + 1] * rs * gg[1]); w[k].y = cvt_pk_bf16(o[d0][4 * g + 2] * rs * gg[2], o[d0][4 * g + 3] * rs * gg[3]); }
                    const u32x2 snd = hi ? w[0] : w[1]; u32x2 rcv; rcv.x = __shfl_xor(snd.x, 32); rcv.y = __shfl_xor(snd.y, 32);
                    const u32x4 c = hi ? (u32x4){rcv.x, rcv.y, w[1].x, w[1].y} : (u32x4){w[0].x, w[0].y, rcv.x, rcv.y};
                    *(u32x4*)(op + 32 * d0 + 8 * (2 * gp + hi)) = c; }
        }
    } else {
        bf16_t* op = MRG + (rowbase + qpos) * DM + 512 + h * 128;
#pragma unroll
        for (int d0 = 0; d0 < 4; ++d0)
#pragma unroll
            for (int gp = 0; gp < 2; ++gp) {
                u32x2 w[2];
#pragma unroll
                for (int k = 0; k < 2; ++k) { const int g = 2 * gp + k;
                    w[k].x = cvt_pk_bf16(o[d0][4 * g] * inv, o[d0][4 * g + 1] * inv); w[k].y = cvt_pk_bf16(o[d0][4 * g + 2] * inv, o[d0][4 * g + 3] * inv); }
                const u32x2 snd = hi ? w[0] : w[1]; u32x2 rcv; rcv.x = __shfl_xor(snd.x, 32); rcv.y = __shfl_xor(snd.y, 32);
                const u32x4 c = hi ? (u32x4){rcv.x, rcv.y, w[1].x, w[1].y} : (u32x4){w[0].x, w[0].y, rcv.x, rcv.y};
                *(u32x4*)(op + 32 * d0 + 8 * (2 * gp + hi)) = c; }
    }
#undef ATT_BAR
}

#define XB_TMO      128
#define XB_XCNT(j)  (256  + 64 * (j))
#define XB_XSUB(j)  (1280 + 64 * (j))
#define XB_XGEN(j)  (2304 + 64 * (j))
#define XB_TOP      3328
#define XB_TOPGEN   3392
#define XCD_BAR_WORDS 3456
#define XB_SPIN_CAP (1u << 18)

__device__ __forceinline__ unsigned xb_ld(unsigned* p)              { return __hip_atomic_load(p, __ATOMIC_RELAXED, __HIP_MEMORY_SCOPE_AGENT); }
__device__ __forceinline__ unsigned xb_add(unsigned* p, unsigned v) { return __hip_atomic_fetch_add(p, v, __ATOMIC_RELAXED, __HIP_MEMORY_SCOPE_AGENT); }
__device__ __forceinline__ unsigned xb_xcc_id() { return (unsigned)__builtin_amdgcn_s_getreg((3 << 11) | 20) & 0xFu; }
#define XB_SPIN(cond, bar) do { unsigned _sp = 0; while (cond) { __builtin_amdgcn_s_sleep(1); \
    if ((++_sp & 255u) == 0u) { if (xb_ld(&(bar)[XB_TMO])) break; if (_sp > XB_SPIN_CAP) { atomicAdd(&(bar)[XB_TMO], 1u); break; } } } } while (0)

struct XcdBarrier {
    unsigned* bar; unsigned x;
    volatile LAS unsigned* st;
};

__device__ __forceinline__ XcdBarrier xcd_barrier_post(unsigned* bar, volatile LAS unsigned* st) {
    XcdBarrier b; b.bar = bar; b.x = xb_xcc_id(); b.st = st;
    if (threadIdx.x == 0) (void)xb_add(&bar[XB_XCNT(b.x)], 1u);
    return b;
}
__device__ __forceinline__ void xcd_barrier_complete(unsigned* bar, unsigned x, unsigned& nloc, unsigned& nx) {
    const unsigned G = gridDim.x * gridDim.y * gridDim.z;
    unsigned sum, cnt, mine, sp = 0u;
    for (;;) {
        sum = 0u; cnt = 0u; mine = 0u;
#pragma unroll
        for (unsigned j = 0; j < 16; ++j) { const unsigned c = xb_ld(&bar[XB_XCNT(j)]); sum += c; cnt += (c > 0u) ? 1u : 0u; mine = (j == x) ? c : mine; }
        if (sum == G) break;
        __builtin_amdgcn_s_sleep(1);
        if ((++sp & 255u) == 0u) { if (xb_ld(&bar[XB_TMO])) break; if (sp > XB_SPIN_CAP) { atomicAdd(&bar[XB_TMO], 1u); break; } }
    }
    nloc = mine > 0u ? mine : 1u; nx = cnt > 0u ? cnt : 1u;
}

__device__ __forceinline__ void xcd_barrier(const XcdBarrier& b) {
    asm volatile("s_waitcnt vmcnt(0)" ::: "memory");
    __syncthreads();
    if (threadIdx.x == 0) {
        unsigned* bar = b.bar;
        __builtin_amdgcn_s_waitcnt(0);
        unsigned nloc = b.st[0], nx = b.st[1];
        if (nloc == 0u) { xcd_barrier_complete(bar, b.x, nloc, nx); b.st[0] = nloc; b.st[1] = nx; }
        const unsigned old = xb_add(&bar[XB_XSUB(b.x)], 1u);
        const unsigned gen = old / nloc;
        if (old + 1u == (gen + 1u) * nloc) {
            __builtin_amdgcn_fence(__ATOMIC_RELEASE, "agent");
            asm volatile("s_waitcnt vmcnt(0)" ::: "memory");
            const unsigned og = xb_add(&bar[XB_TOP], 1u);
            const unsigned tg = og / nx;
            if (og + 1u == (tg + 1u) * nx) xb_add(&bar[XB_TOPGEN], 1u);
            else XB_SPIN(xb_ld(&bar[XB_TOPGEN]) == tg, bar);
            __builtin_amdgcn_fence(__ATOMIC_ACQUIRE, "agent");
            xb_add(&bar[XB_XGEN(b.x)], 1u);
            asm volatile("s_waitcnt vmcnt(0)" ::: "memory");
        } else {
            XB_SPIN(xb_ld(&bar[XB_XGEN(b.x)]) == gen, bar);
            __builtin_amdgcn_fence(__ATOMIC_ACQUIRE, "agent");
            asm volatile("s_waitcnt vmcnt(0)" ::: "memory");
        }
    }
    __syncthreads();
}


__global__ void __launch_bounds__(512, 2) fwd_kernel(Args a) {
    extern __shared__ __attribute__((aligned(16))) unsigned char lds_raw[];
    LAS unsigned char* lds = (LAS unsigned char*)lds_raw;
    cg::grid_group grid = cg::this_grid();
    const int tid = threadIdx.x, lane = tid & 63, wave = __builtin_amdgcn_readfirstlane(tid >> 6);
    const int G = gridDim.x, bx = blockIdx.x, vcu = (G % 8 == 0) ? (bx % 8) * (G / 8) + bx / 8 : bx;
    unsigned char* ws = a.ws;
    bf16_t *WIN = (bf16_t*)(ws + WS_WIN), *WQ = (bf16_t*)(ws + WS_WQ), *WKV = (bf16_t*)(ws + WS_WKV), *WOUT = (bf16_t*)(ws + WS_WOUT), *WGU = (bf16_t*)(ws + WS_WGU), *WDN = (bf16_t*)(ws + WS_WDN);
    float *MOD = (float*)(ws + WS_MOD), *CS = (float*)(ws + WS_CS), *SS = (float*)(ws + WS_SS); unsigned* CNT = (unsigned*)(ws + WS_SS2);
    bf16_t *XN = (bf16_t*)(ws + WS_XN), *PROJ = (bf16_t*)(ws + WS_PROJ), *QBUF = (bf16_t*)(ws + WS_Q), *KVB = (bf16_t*)(ws + WS_KV), *MRG = (bf16_t*)(ws + WS_MRG), *ACT = (bf16_t*)(ws + WS_ACT);
    bf16_t *X1B = KVB, *X2B = XN;
    const int lo = a.ph_lo, hi = a.ph_hi;
#ifndef PH_MASK
#define PH_MASK 0x3ff
#endif
#define IN(k) (((PH_MASK >> (k)) & 1) && lo <= (k) && (k) < hi)
    volatile LAS unsigned* xst = (volatile LAS unsigned*)(lds + RING_BYTES + 128);
    if (tid == 0) { xst[0] = 0u; xst[1] = 0u; }
    XcdBarrier xbar; xbar.bar = (unsigned*)ws; xbar.x = 0; xbar.st = xst;
#define SEAM(k) do { if (IN((k) + 1)) { if ((k) == 0) { grid.sync(); xbar = xcd_barrier_post((unsigned*)ws, xst); } else xcd_barrier(xbar); } } while (0)

    if (IN(0)) {
        if (bx == G - 1) { CNT[tid] = 0u; for (int i = tid; i < XCD_BAR_WORDS; i += 512) ((unsigned*)ws)[i] = 0u; }
        for (int it = bx; it < 96; it += G) adaln_item(a, MOD, lds, it);
        LAS float* scr = (LAS float*)(lds + wave * 16384);
        const int tfirst = (G > 128) ? 96 : 0;
        const int gw = (bx - tfirst) * 8 + wave, NGW = (G - tfirst) * 8;
        constexpr int I_IN = 16 * 72, I_Q = 6 * 24, I_KV = 4 * 32, I_O = 16 * 32, I_GU = 16 * 176, I_DN = 44 * 32;
        constexpr int NITEMS = I_IN + I_Q + I_KV + I_O + I_GU + I_DN;
        for (int it = (bx >= tfirst) ? gw : NITEMS; it < NITEMS; it += NGW) {
            int r = it;
            if (r < I_IN) { transpose_item(a.w_in, nullptr, 1024, 2240, WIN, 0, nullptr, scr, r, 72, lane); continue; } r -= I_IN;
            if (r < I_Q) { transpose_item(a.w_q_up, nullptr, KQ, NQ, WQ, 1, a.g_q_lat, scr, r, 24, lane); continue; } r -= I_Q;
            if (r < I_KV) { transpose_item(a.w_kv_up, nullptr, KKV, NKV, WKV, 2, a.g_kv_lat, scr, r, 32, lane); continue; } r -= I_KV;
            if (r < I_O) { transpose_item(a.w_out, nullptr, 1024, 1024, WOUT, 2, nullptr, scr, r, 32, lane); continue; } r -= I_O;
            if (r < I_GU) { transpose_item(a.w_gate, a.w_up, 1024, NFF, WGU, 3, nullptr, scr, r, 176, lane); continue; } r -= I_GU;
            transpose_item(a.w_down, nullptr, NFF, 1024, WDN, 2, nullptr, scr, r, 32, lane);
        }
        for (int e = bx * 512 + tid; e < SEQ * 32; e += G * 512) {
            const int t = e >> 5, i = e & 31;
            const float invf = __builtin_amdgcn_exp2f(-(float)i * (13.287712379549449f / 32.0f));
            const float ang = (float)t * invf;
            const double ad = (double)ang, kk = __builtin_rint(ad * 0.15915494309189535);
            const float rr = (float)(ad - kk * 6.283185307179586);
            CS[2 * e] = __cosf(rr); CS[2 * e + 1] = __sinf(rr);
        }
        SEAM(0);
    }
    if (IN(1)) {
        const int gw = vcu * 8 + wave, NGW = G * 8;
        for (int m = gw * 32; m < TOK; m += NGW * 32) { const float* mb = MOD + (size_t)(m >> 11) * 6144; modnorm_rows32(a.x, XN, a.g_mix, mb + 1024, mb, m, lane); }
        SEAM(1);
    }
    if (IN(2)) {
        pg8::Gemm g{XN, WIN, TOK, NPROJ, 1024, 1024}; pg8::StaticOrder S; S.init(TOK, NPROJ, G, bx);
        EpiInProj E{PROJ, SS, CS};
        pg8::gemm_phase<EpiInProj, true>(lds, g, S, E);
        SEAM(2);
    }
    if (IN(3)) {
        { pg8::Gemm g{PROJ + 1536, WQ, TOK, NQ, KQ, NPROJ}; pg8::StaticOrder S; S.init(TOK, NQ, G, bx); EpiQUp E{QBUF, SS, CS}; pg8::gemm_phase<EpiQUp, true>(lds, g, S, E); }
        { pg8::Gemm g{PROJ + 1920, WKV, TOK, NKV, KKV, NPROJ}; pg8::StaticOrder S; S.init(TOK, NKV, G, bx); EpiKvUp E{KVB, SS}; pg8::gemm_phase<EpiKvUp, true>(lds, g, S, E); }
        SEAM(3);
    }
    if (IN(4)) {
        float d1 = a.lq1[lane] * a.lk1[lane], d2 = a.lq2[lane] * a.lk2[lane];
        const float lam = __expf(wave_sum(d1)) - __expf(wave_sum(d2)) + LAMBDA_INIT;
        for (int pp = vcu; pp < 1024; pp += G)
            { { const int bh = pp >> 3, pr = pp & 7;
                attn_unit<true>(lds, PROJ, QBUF, KVB, MRG, a.g_diff_out, lam, bh >> 2, bh & 3, 15 - pr);
                attn_unit<true>(lds, PROJ, QBUF, KVB, MRG, a.g_diff_out, lam, bh >> 2, bh & 3, pr); } }
        for (int pp = vcu; pp < 512; pp += G)
            { { const int bh = pp >> 2, pr = pp & 3;
                attn_unit<false>(lds, PROJ, QBUF, KVB, MRG, a.g_diff_out, lam, bh >> 2, bh & 3, 7 - pr);
                attn_unit<false>(lds, PROJ, QBUF, KVB, MRG, a.g_diff_out, lam, bh >> 2, bh & 3, pr); } }
        __syncthreads();
        SEAM(4);
    }
    if (IN(5)) {
        pg8::Gemm g{MRG, WOUT, TOK, 1024, 1024, 1024}; pg8::StaticOrder S; S.init(TOK, 1024, G, bx);
        EpiResGate<0> E{a.x, nullptr, X1B, MOD + 2048, CNT, lds, XN, nullptr, a.g_ffn, MOD, -1, 0, -1, 0};
        pg8::gemm_phase<EpiResGate<0>, true>(lds, g, S, E);
        E.finish();
        if (IN(7)) xcd_barrier(xbar);
    }
    if (IN(7)) {
        pg8::Gemm g{XN, WGU, TOK, NGU, 1024, 1024}; pg8::StaticOrder S; S.init(TOK, NGU, G, bx);
        EpiSwiGLU E{ACT};
        pg8::gemm_phase<EpiSwiGLU, true>(lds, g, S, E);
        SEAM(7);
    }
    if (IN(8)) {
        pg8::Gemm g{ACT, WDN, TOK, 1024, NFF, NFF}; pg8::StaticOrder S; S.init(TOK, 1024, G, bx);
        EpiResGate<1> E{nullptr, X1B, X2B, MOD + 5120, CNT + 256, lds, nullptr, a.out, a.g_final, MOD, -1, 0, -1, 0};
        pg8::gemm_phase<EpiResGate<1>, true>(lds, g, S, E);
        E.finish();
    }
#undef IN
#undef SEAM
}

extern "C" void kernel_launch(void* const* d_in, const int* in_sizes, int n_in, void* d_out, int out_size, void* d_ws, size_t ws_size, hipStream_t stream) {
    static int grid = 0;
    if (grid == 0) {
        if (n_in != 21 || in_sizes[0] != TOK * DM || out_size != TOK * DM || ws_size < WS_END) { fprintf(stderr, "kernel_launch: unexpected shapes (n_in %d, ws %zu)\n", n_in, ws_size); grid = -1; return; }
        int dev = 0, cus = 0, per_cu = 0;
        if (hipGetDevice(&dev) != hipSuccess || hipDeviceGetAttribute(&cus, hipDeviceAttributeMultiprocessorCount, dev) != hipSuccess) { grid = -1; return; }
        if (hipFuncSetAttribute((const void*)fwd_kernel, hipFuncAttributeMaxDynamicSharedMemorySize, LDS_BYTES) != hipSuccess) { fprintf(stderr, "kernel_launch: hipFuncSetAttribute failed\n"); grid = -1; return; }
        if (hipOccupancyMaxActiveBlocksPerMultiprocessor(&per_cu, (const void*)fwd_kernel, 512, LDS_BYTES) != hipSuccess || per_cu < 1) { fprintf(stderr, "kernel_launch: occupancy query gave %d\n", per_cu); per_cu = 1; }
        (void)hipGetLastError();
        grid = cus * (per_cu > 1 ? 1 : per_cu);
    }
    if (grid < 0) return;
    Args a{};
    const float** fp = (const float**)&a;
    for (int i = 0; i < 21; ++i) fp[i] = (const float*)d_in[i];
    a.out = (float*)d_out; a.ws = (unsigned char*)d_ws;
#if MK_NL == 1
    a.ph_lo = 0; a.ph_hi = 10;
    void* args[] = {&a};
    hipError_t e = hipLaunchCooperativeKernel((const void*)fwd_kernel, dim3(grid), dim3(512), args, LDS_BYTES, stream);
    if (e != hipSuccess) fprintf(stderr, "cooperative launch failed: %s (grid %d)\n", hipGetErrorString(e), grid);
#else
#ifndef PROBE_SEQ
#define PROBE_SEQ 0, 1, 2, 3, 4, 5, 7, 8
#endif
    static const int seq[] = {PROBE_SEQ};
    for (unsigned i = 0; i < sizeof(seq) / sizeof(seq[0]); ++i) { const int k = seq[i]; a.ph_lo = k; a.ph_hi = k + 1; hipLaunchKernelGGL(fwd_kernel, dim3(grid), dim3(512), LDS_BYTES, stream, a); }
#endif
}
```

```cpp
#include <hip/hip_runtime.h>
#include <hip/hip_cooperative_groups.h>
#include <cstdio>
#include <cstdint>
namespace cg = cooperative_groups;

#ifndef MK_NL
#define MK_NL 1
#endif

#define LAS __attribute__((address_space(3)))
typedef unsigned short bf16_t;
typedef short bf16x8 __attribute__((ext_vector_type(8)));
typedef short s16x4 __attribute__((ext_vector_type(4)));
typedef float f32x4 __attribute__((ext_vector_type(4)));
typedef float f32x16 __attribute__((ext_vector_type(16)));
typedef unsigned u32x4 __attribute__((ext_vector_type(4)));
typedef unsigned u32x2 __attribute__((ext_vector_type(2)));

constexpr int NB = 32, SEQ = 2048, DM = 1024, TOK = NB * SEQ;
constexpr int NPROJ = 2304;
constexpr int NQ = 768, NKV = 1024, NFF = 2816, NGU = 2 * NFF;
constexpr int KQ = 384, KKV = 256;
constexpr float EPS = 1e-6f, LOG2E = 1.4426950408889634f;
constexpr float QS_DIFF = 0.125f * LOG2E;
constexpr float QS_MLA = 0.07216878364870322f * LOG2E;
constexpr float LAMBDA_INIT = 0.2f;

constexpr size_t MiB = 1u << 20;
constexpr size_t WS_WIN = 1 * MiB, WS_WQ = 6 * MiB, WS_WKV = 7 * MiB, WS_WOUT = 8 * MiB, WS_WGU = 10 * MiB, WS_WDN = 21 * MiB;
constexpr size_t WS_MOD = 27 * MiB, WS_CS = 28 * MiB, WS_SS = 29 * MiB, WS_SS2 = 34 * MiB;
constexpr size_t WS_XN = 64 * MiB, WS_PROJ = 192 * MiB, WS_Q = 480 * MiB, WS_KV = 576 * MiB, WS_MRG = 704 * MiB, WS_ACT = 192 * MiB, WS_END = 832 * MiB;

constexpr int RING_BYTES = 131072, LDS_BYTES = 147456;

__device__ __forceinline__ unsigned cvt_pk_bf16(float lo, float hi) { unsigned r; asm volatile("v_cvt_pk_bf16_f32 %0, %1, %2" : "=v"(r) : "v"(lo), "v"(hi)); return r; }
__device__ __forceinline__ unsigned f2bf(float f) { unsigned u = __builtin_bit_cast(unsigned, f); return (u + 0x7fffu + ((u >> 16) & 1u)) >> 16; }
__device__ __forceinline__ unsigned pk2(float lo, float hi) { return f2bf(lo) | (f2bf(hi) << 16); }
__device__ __forceinline__ u32x4 pack8(const f32x4 v0, const f32x4 v1) { u32x4 w; w.x = cvt_pk_bf16(v0[0], v0[1]); w.y = cvt_pk_bf16(v0[2], v0[3]); w.z = cvt_pk_bf16(v1[0], v1[1]); w.w = cvt_pk_bf16(v1[2], v1[3]); return w; }
__device__ __forceinline__ float wave_sum(float v) {
#pragma unroll
    for (int o = 1; o < 64; o <<= 1) v += __shfl_xor(v, o);
    return v;
}

namespace pg8 {
constexpr int BM = 256, BK = 64, HALF = 128, HTB = HALF * BK * 2, STAGE_BYTES = 8 * HTB, NXCD = 8, WGM = 8;
__host__ __device__ __forceinline__ int lds_byte(int r, int c) { const int st = (r >> 4) * 2 + (c >> 5), rr = r & 15, cc = c & 31, ob = rr * 64 + cc * 2; return st * 1024 + (ob ^ (((ob >> 9) & 1) << 5)); }
__host__ __device__ __forceinline__ void stage_rc(int b, int& R, int& C) { const int st = b / 1024, sb = b % 1024, swz = sb ^ (((sb >> 9) & 1) << 5); R = (st >> 1) * 16 + swz / 64; C = (st & 1) * 32 + (swz % 64) / 2; }
__host__ __device__ __forceinline__ int perm32(int rho) { const int n = rho >> 4, i = rho & 15; return 8 * (i >> 2) + 4 * n + (i & 3); }

struct Unit { int pm, pn; };
struct Gemm { const bf16_t* A; const bf16_t* Bt; int M, N, K, lda; };

struct StaticOrder {
    int nM, nN, nwg, G, c;
    __device__ void init(int M, int N, int G_, int c_) { nM = M / BM; nN = N / BM; nwg = nM * nN; G = G_; c = c_; }
    __device__ bool next(int i, Unit& u) const {
        const long L = (long)i * G + c; if (L >= nwg) return false;
        int wgid = (int)L; { const int q = nwg / NXCD, r = nwg % NXCD, xcd = wgid % NXCD, off = wgid / NXCD; wgid = (xcd < r ? xcd * (q + 1) : r * (q + 1) + (xcd - r) * q) + off; }
        const int nig = WGM * nN, gid = wgid / nig, fm = gid * WGM, gsz = (nM - fm) < WGM ? (nM - fm) : WGM;
        u.pm = fm + ((wgid % nig) % gsz); u.pn = (wgid % nig) / gsz; return true;
    }
};

template <class Epi, bool ALIGN_EPI>
__device__ __forceinline__ void gemm_phase(LAS unsigned char* lds, const Gemm g, const StaticOrder& S, Epi& E) {
    const int tid = threadIdx.x, wid = __builtin_amdgcn_readfirstlane(tid >> 6), lane = tid & 63, wr = wid >> 2, wc = wid & 3, fr = lane & 15, fq = lane >> 4;
    const int K = g.K, nt = K / BK, lda = g.lda;
    unsigned voffA[2], voffB[2];
#pragma unroll
    for (int i = 0; i < 2; ++i) { int R, C; stage_rc(tid * 16 + i * 8192, R, C); const int Rb = Epi::PERM ? ((R & ~31) + perm32(R & 31)) : R;
        voffA[i] = (unsigned)(R * lda + C) * 2u; voffB[i] = (unsigned)(Rb * K + C) * 2u; }
    const size_t kstep = (size_t)(BK * 2);
    const size_t hstepA = (size_t)HALF * lda * 2, hstepB = (size_t)HALF * K * 2;
    const size_t tstepA = 2 * hstepA, tstepB = 2 * hstepB;
    const unsigned ldsw = (unsigned)wid * 1024u;
    const int aoff = lds_byte(wr * 64 + fr, fq * 8), boff = lds_byte(wc * 32 + fr, fq * 8);
#define PG8_SA(b, h) (((b) * 2 + (h)) * HTB)
#define PG8_SB(b, h) ((4 + (b) * 2 + (h)) * HTB)
#define PG8_STAGE(bufoff, gbase, voff) do { _Pragma("unroll") for (int _i = 0; _i < 2; ++_i) \
        __builtin_amdgcn_global_load_lds((const unsigned*)((const char*)(gbase) + (voff)[_i]), (LAS unsigned*)(lds + (bufoff) + ldsw + _i * 8192), 16, 0, 0); } while (0)
#define PG8_LDA(dst, b, h) do { _Pragma("unroll") for (int m = 0; m < 4; ++m) _Pragma("unroll") for (int k = 0; k < 2; ++k) dst[m][k] = *(const LAS bf16x8*)(lds + PG8_SA(b, h) + aoff + m * 2048 + k * 1024); } while (0)
#define PG8_LDB(dst, b, h) do { _Pragma("unroll") for (int n = 0; n < 2; ++n) _Pragma("unroll") for (int k = 0; k < 2; ++k) dst[n][k] = *(const LAS bf16x8*)(lds + PG8_SB(b, h) + boff + n * 2048 + k * 1024); } while (0)
#define PG8_MMA(ai, bj, At, Bt) do { __builtin_amdgcn_s_setprio(1); _Pragma("unroll") for (int m = 0; m < 4; ++m) _Pragma("unroll") for (int n = 0; n < 2; ++n) _Pragma("unroll") for (int k = 0; k < 2; ++k) \
        acc[ai][bj][m][n] = __builtin_amdgcn_mfma_f32_16x16x32_bf16(Bt[n][k], At[m][k], acc[ai][bj][m][n], 0, 0, 0); __builtin_amdgcn_s_setprio(0); } while (0)
#define PG8_WAIT_V(n) asm volatile("s_waitcnt vmcnt(" #n ")" ::: "memory")
#define PG8_WAIT_L(n) asm volatile("s_waitcnt lgkmcnt(" #n ")" ::: "memory")
#define PG8_BAR __builtin_amdgcn_s_barrier()
#define PG8_SCHED __builtin_amdgcn_sched_barrier(0)
    Unit cur, nxt; int ui = 0;
    if (!S.next(0, cur)) return;
    f32x4 acc[2][2][4][2];
#pragma unroll
    for (int a = 0; a < 2; ++a)
#pragma unroll
        for (int b = 0; b < 2; ++b)
#pragma unroll
            for (int m = 0; m < 4; ++m)
#pragma unroll
                for (int n = 0; n < 2; ++n) acc[a][b][m][n] = (f32x4){0.f, 0.f, 0.f, 0.f};
    bf16x8 At[4][2], B0[2][2], B1[2][2];
    const char* cA = (const char*)g.A + (size_t)cur.pm * tstepA; const char* cB = (const char*)g.Bt + (size_t)cur.pn * tstepB;
    PG8_STAGE(PG8_SB(0, 0), cB, voffB); PG8_STAGE(PG8_SB(0, 1), cB + hstepB, voffB); PG8_STAGE(PG8_SA(0, 0), cA, voffA); PG8_STAGE(PG8_SA(0, 1), cA + hstepA, voffA);
    if (wr == 1) PG8_BAR;
    PG8_WAIT_V(2); PG8_BAR;
    PG8_STAGE(PG8_SB(1, 0), cB + kstep, voffB); PG8_STAGE(PG8_SA(1, 0), cA + kstep, voffA); PG8_STAGE(PG8_SB(1, 1), cB + hstepB + kstep, voffB);
    PG8_WAIT_V(6); PG8_BAR;
    for (;;) {
        const bool has_next = S.next(ui + 1, nxt);
        const char* nA = has_next ? (const char*)g.A + (size_t)nxt.pm * tstepA : cA; const char* nB = has_next ? (const char*)g.Bt + (size_t)nxt.pn * tstepB : cB;
#pragma unroll 1
        for (int t = 0; t < nt; t += 2) {
            const bool last = (t == nt - 2);
            const char* a1 = cA + (size_t)(t + 1) * kstep;
            const char* a2 = last ? nA : cA + (size_t)(t + 2) * kstep; const char* b2 = last ? nB : cB + (size_t)(t + 2) * kstep;
            const char* a3 = a2 + kstep; const char* b3 = b2 + kstep;
            PG8_LDB(B0, 0, 0); PG8_LDB(B1, 0, 1); PG8_SCHED; PG8_LDA(At, 0, 0); PG8_STAGE(PG8_SA(1, 1), a1 + hstepA, voffA);
            PG8_WAIT_V(8); PG8_WAIT_L(0); PG8_BAR; PG8_MMA(0, 0, At, B0); PG8_MMA(0, 1, At, B1); PG8_BAR; PG8_SCHED;
            PG8_LDA(At, 0, 1); PG8_STAGE(PG8_SB(0, 0), b2, voffB); PG8_STAGE(PG8_SB(0, 1), b2 + hstepB, voffB); PG8_STAGE(PG8_SA(0, 0), a2, voffA);
            PG8_WAIT_V(8); PG8_WAIT_L(0); PG8_BAR; PG8_MMA(1, 0, At, B0); PG8_MMA(1, 1, At, B1); PG8_BAR; PG8_SCHED;
            PG8_LDB(B0, 1, 0); PG8_LDB(B1, 1, 1); PG8_SCHED; PG8_LDA(At, 1, 0); PG8_STAGE(PG8_SA(0, 1), a2 + hstepA, voffA);
            PG8_WAIT_V(8); PG8_WAIT_L(0); PG8_BAR; PG8_MMA(0, 0, At, B0); PG8_MMA(0, 1, At, B1); PG8_BAR; PG8_SCHED;
            PG8_LDA(At, 1, 1); PG8_STAGE(PG8_SB(1, 0), b3, voffB); PG8_STAGE(PG8_SB(1, 1), b3 + hstepB, voffB); PG8_STAGE(PG8_SA(1, 0), a3, voffA);
            PG8_WAIT_V(8); PG8_WAIT_L(0); PG8_BAR; PG8_MMA(1, 0, At, B0); PG8_MMA(1, 1, At, B1); PG8_BAR; PG8_SCHED;
        }
        if constexpr (ALIGN_EPI) { if (wr == 0) PG8_BAR; }
        E(acc, cur, wr, wc, fr, fq);
        if (!has_next) break;
#pragma unroll
        for (int a = 0; a < 2; ++a)
#pragma unroll
            for (int b = 0; b < 2; ++b)
#pragma unroll
                for (int m = 0; m < 4; ++m)
#pragma unroll
                    for (int n = 0; n < 2; ++n) acc[a][b][m][n] = (f32x4){0.f, 0.f, 0.f, 0.f};
        cur = nxt; cA = nA; cB = nB; ++ui;
        if constexpr (ALIGN_EPI) { if (wr == 1) PG8_BAR; }
    }
    PG8_WAIT_V(0);
    if constexpr (!ALIGN_EPI) { if (wr == 0) PG8_BAR; }
    PG8_BAR;
#undef PG8_SA
#undef PG8_SB
#undef PG8_STAGE
#undef PG8_LDA
#undef PG8_LDB
#undef PG8_MMA
#undef PG8_WAIT_V
#undef PG8_WAIT_L
#undef PG8_BAR
#undef PG8_SCHED
}
}

__device__ __forceinline__ void modnorm_rows32(const float* X, bf16_t* O, const float* g, const float* sc, const float* sh, int m0, int lane, int nrows = 32) {
    f32x4 ga[4], hb[4];
#pragma unroll
    for (int j = 0; j < 4; ++j) { const int c = 4 * lane + 256 * j; ga[j] = *(const f32x4*)(g + c) * (*(const f32x4*)(sc + c) + 1.0f); hb[j] = *(const f32x4*)(sh + c); }
#pragma unroll 1
    for (int r0 = 0; r0 < nrows; r0 += 4) {
        f32x4 v[4][4]; float s[4];
#pragma unroll
        for (int i = 0; i < 4; ++i) { const f32x4* xr = (const f32x4*)(X + (size_t)(m0 + r0 + i) * DM) + lane;
#pragma unroll
            for (int j = 0; j < 4; ++j) v[i][j] = xr[64 * j]; }
#pragma unroll
        for (int i = 0; i < 4; ++i) { s[i] = 0.f;
#pragma unroll
            for (int j = 0; j < 4; ++j) s[i] += (v[i][j][0] * v[i][j][0] + v[i][j][1] * v[i][j][1]) + (v[i][j][2] * v[i][j][2] + v[i][j][3] * v[i][j][3]); }
#pragma unroll
        for (int o = 1; o < 64; o <<= 1) {
#pragma unroll
            for (int i = 0; i < 4; ++i) s[i] += __shfl_xor(s[i], o); }
#pragma unroll
        for (int i = 0; i < 4; ++i) { const float rstd = 1.0f / sqrtf(s[i] * (1.0f / DM) + EPS); bf16_t* orow = O + (size_t)(m0 + r0 + i) * DM;
#pragma unroll
            for (int j = 0; j < 4; ++j) { const f32x4 y = v[i][j] * rstd * ga[j] + hb[j];
                u32x2 w; w.x = cvt_pk_bf16(y[0], y[1]); w.y = cvt_pk_bf16(y[2], y[3]);
                *(u32x2*)(orow + 4 * lane + 256 * j) = w; } }
    }
}

__device__ __forceinline__ void finalnorm_rows32(float* X, const float* g, int m0, int lane, int nrows = 32) {
    f32x4 gf[4];
#pragma unroll
    for (int j = 0; j < 4; ++j) gf[j] = *(const f32x4*)(g + 4 * lane + 256 * j);
#pragma unroll 1
    for (int r0 = 0; r0 < nrows; r0 += 4) {
        f32x4 v[4][4]; float s[4];
#pragma unroll
        for (int i = 0; i < 4; ++i) { const f32x4* xr = (const f32x4*)(X + (size_t)(m0 + r0 + i) * DM) + lane;
#pragma unroll
            for (int j = 0; j < 4; ++j) v[i][j] = xr[64 * j]; }
#pragma unroll
        for (int i = 0; i < 4; ++i) { s[i] = 0.f;
#pragma unroll
            for (int j = 0; j < 4; ++j) s[i] += (v[i][j][0] * v[i][j][0] + v[i][j][1] * v[i][j][1]) + (v[i][j][2] * v[i][j][2] + v[i][j][3] * v[i][j][3]); }
#pragma unroll
        for (int o = 1; o < 64; o <<= 1) {
#pragma unroll
            for (int i = 0; i < 4; ++i) s[i] += __shfl_xor(s[i], o); }
#pragma unroll
        for (int i = 0; i < 4; ++i) { const float rstd = 1.0f / sqrtf(s[i] * (1.0f / DM) + EPS); f32x4* xr = (f32x4*)(X + (size_t)(m0 + r0 + i) * DM) + lane;
#pragma unroll
            for (int j = 0; j < 4; ++j) xr[64 * j] = v[i][j] * rstd * gf[j]; }
    }
}
__device__ __forceinline__ void unpack8(const u32x4 w, f32x4& a, f32x4& b) {
    a[0] = __uint_as_float(w.x << 16); a[1] = __uint_as_float(w.x & 0xffff0000u); a[2] = __uint_as_float(w.y << 16); a[3] = __uint_as_float(w.y & 0xffff0000u);
    b[0] = __uint_as_float(w.z << 16); b[1] = __uint_as_float(w.z & 0xffff0000u); b[2] = __uint_as_float(w.w << 16); b[3] = __uint_as_float(w.w & 0xffff0000u);
}
__device__ __forceinline__ float wave_sum4(float (&s)[4]) {
#pragma unroll
    for (int o = 1; o < 64; o <<= 1) {
#pragma unroll
        for (int i = 0; i < 4; ++i) s[i] += __shfl_xor(s[i], o); }
    return 0.f;
}
__device__ __forceinline__ void modnorm_rows_b(const bf16_t* X, bf16_t* O, const float* g, const float* sc, const float* sh, int m0, int lane, int nrows) {
    f32x4 ga[4], hb[4];
#pragma unroll
    for (int j = 0; j < 4; ++j) { const int c = 8 * lane + 512 * (j >> 1) + 4 * (j & 1); ga[j] = *(const f32x4*)(g + c) * (*(const f32x4*)(sc + c) + 1.0f); hb[j] = *(const f32x4*)(sh + c); }
#pragma unroll 1
    for (int r0 = 0; r0 < nrows; r0 += 4) {
        u32x4 w[4][2]; f32x4 v[4][4]; float s[4];
#pragma unroll
        for (int i = 0; i < 4; ++i) { const u32x4* xr = (const u32x4*)(X + (size_t)(m0 + r0 + i) * DM) + lane; w[i][0] = xr[0]; w[i][1] = xr[64]; }
#pragma unroll
        for (int i = 0; i < 4; ++i) { unpack8(w[i][0], v[i][0], v[i][1]); unpack8(w[i][1], v[i][2], v[i][3]); s[i] = 0.f;
#pragma unroll
            for (int j = 0; j < 4; ++j) s[i] += (v[i][j][0] * v[i][j][0] + v[i][j][1] * v[i][j][1]) + (v[i][j][2] * v[i][j][2] + v[i][j][3] * v[i][j][3]); }
        wave_sum4(s);
#pragma unroll
        for (int i = 0; i < 4; ++i) { const float rstd = 1.0f / sqrtf(s[i] * (1.0f / DM) + EPS); u32x4* orow = (u32x4*)(O + (size_t)(m0 + r0 + i) * DM) + lane;
            const f32x4 y0 = v[i][0] * rstd * ga[0] + hb[0], y1 = v[i][1] * rstd * ga[1] + hb[1], y2 = v[i][2] * rstd * ga[2] + hb[2], y3 = v[i][3] * rstd * ga[3] + hb[3];
            orow[0] = pack8(y0, y1); orow[64] = pack8(y2, y3); }
    }
}
__device__ __forceinline__ void finalnorm_rows_b(const bf16_t* X, float* OUT, const float* g, int m0, int lane, int nrows) {
    f32x4 gf[4];
#pragma unroll
    for (int j = 0; j < 4; ++j) gf[j] = *(const f32x4*)(g + 8 * lane + 512 * (j >> 1) + 4 * (j & 1));
#pragma unroll 1
    for (int r0 = 0; r0 < nrows; r0 += 4) {
        u32x4 w[4][2]; f32x4 v[4][4]; float s[4];
#pragma unroll
        for (int i = 0; i < 4; ++i) { const u32x4* xr = (const u32x4*)(X + (size_t)(m0 + r0 + i) * DM) + lane; w[i][0] = xr[0]; w[i][1] = xr[64]; }
#pragma unroll
        for (int i = 0; i < 4; ++i) { unpack8(w[i][0], v[i][0], v[i][1]); unpack8(w[i][1], v[i][2], v[i][3]); s[i] = 0.f;
#pragma unroll
            for (int j = 0; j < 4; ++j) s[i] += (v[i][j][0] * v[i][j][0] + v[i][j][1] * v[i][j][1]) + (v[i][j][2] * v[i][j][2] + v[i][j][3] * v[i][j][3]); }
        wave_sum4(s);
#pragma unroll
        for (int i = 0; i < 4; ++i) { const float rstd = 1.0f / sqrtf(s[i] * (1.0f / DM) + EPS); f32x4* orow = (f32x4*)(OUT + (size_t)(m0 + r0 + i) * DM) + 2 * lane;
            orow[0] = v[i][0] * rstd * gf[0]; orow[1] = v[i][1] * rstd * gf[1]; orow[128] = v[i][2] * rstd * gf[2]; orow[129] = v[i][3] * rstd * gf[3]; }
    }
}

__device__ __forceinline__ bool panel_arrive_last(unsigned* cnt, int pm, unsigned ntiles, LAS unsigned char* lds) {
    asm volatile("s_waitcnt vmcnt(0)" ::: "memory");
    __syncthreads();
    LAS unsigned* flag = (LAS unsigned*)(lds + RING_BYTES + 64);
    if (threadIdx.x == 0) {
        const unsigned old = __hip_atomic_fetch_add(cnt + pm, 1u, __ATOMIC_RELAXED, __HIP_MEMORY_SCOPE_AGENT);
        const bool last = (old == ntiles - 1u);
        if (last) { __builtin_amdgcn_fence(__ATOMIC_ACQUIRE, "agent"); asm volatile("s_waitcnt vmcnt(0)" ::: "memory"); }
        *flag = last ? 1u : 0u;
    }
    __syncthreads();
    return *flag != 0u;
}

typedef const f32x4 (&AccRef)[2][2][4][2];

__device__ __forceinline__ void rope8(f32x4& v0, f32x4& v1, const float* cs, int t, int i0) {
    const f32x4 a = *(const f32x4*)(cs + ((size_t)t * 32 + i0) * 2), b = *(const f32x4*)(cs + ((size_t)t * 32 + i0 + 2) * 2);
    f32x4 o0, o1;
    o0[0] = v0[0] * a[0] - v0[1] * a[1]; o0[1] = v0[0] * a[1] + v0[1] * a[0];
    o0[2] = v0[2] * a[2] - v0[3] * a[3]; o0[3] = v0[2] * a[3] + v0[3] * a[2];
    o1[0] = v1[0] * b[0] - v1[1] * b[1]; o1[1] = v1[0] * b[1] + v1[1] * b[0];
    o1[2] = v1[2] * b[2] - v1[3] * b[3]; o1[3] = v1[2] * b[3] + v1[3] * b[2];
    v0 = o0; v1 = o1;
}

struct EpiInProj {
    static constexpr bool PERM = true;
    bf16_t* O; float* SS; const float* cs;
    __device__ __forceinline__ void operator()(AccRef acc, const pg8::Unit& u, int wr, int wc, int fr, int fq) const {
        const int row0 = u.pm * 256 + wr * 64 + fr, colt = u.pn * 256;
#pragma unroll
        for (int ai = 0; ai < 2; ++ai)
#pragma unroll
            for (int m = 0; m < 4; ++m) { const int row = row0 + ai * 128 + m * 16;
#pragma unroll
                for (int bj = 0; bj < 2; ++bj) {
                    f32x4 v0 = acc[ai][bj][m][0], v1 = acc[ai][bj][m][1];
                    const int slab = (colt + bj * 128 + wc * 32) >> 5;
                    if (slab >= 48 && slab < 68) {
                        float ss = (v0[0] * v0[0] + v0[1] * v0[1]) + (v0[2] * v0[2] + v0[3] * v0[3]) + (v1[0] * v1[0] + v1[1] * v1[1]) + (v1[2] * v1[2] + v1[3] * v1[3]);
                        ss += __shfl_xor(ss, 16); ss += __shfl_xor(ss, 32);
                        if (fq == 0) SS[(size_t)row * 20 + (slab - 48)] = ss;
                    }
                    if (slab < 16) { v0 = v0 * QS_DIFF; v1 = v1 * QS_DIFF; }
                    if (slab == 68 || slab == 69) rope8(v0, v1, cs, row & (SEQ - 1), (slab - 68) * 16 + fq * 4);
                    *(u32x4*)(O + (size_t)row * NPROJ + colt + bj * 128 + wc * 32 + 8 * fq) = pack8(v0, v1);
                } }
    }
};
struct EpiQUp {
    static constexpr bool PERM = true;
    bf16_t* O; const float* SS; const float* cs;
    __device__ __forceinline__ void operator()(AccRef acc, const pg8::Unit& u, int wr, int wc, int fr, int fq) const {
        const int row0 = u.pm * 256 + wr * 64 + fr, colt = u.pn * 256;
        float scl[2];
#pragma unroll
        for (int ai = 0; ai < 2; ++ai) { const float* sp = SS + (size_t)(u.pm * 256 + wr * 64 + ai * 128 + fq * 16 + fr) * 20;
            const f32x4 s0 = *(const f32x4*)(sp), s1 = *(const f32x4*)(sp + 4), s2 = *(const f32x4*)(sp + 8);
            const float ss = ((s0[0] + s0[1]) + (s0[2] + s0[3])) + ((s1[0] + s1[1]) + (s1[2] + s1[3])) + ((s2[0] + s2[1]) + (s2[2] + s2[3]));
            scl[ai] = QS_MLA / sqrtf(ss * (1.0f / KQ) + EPS); }
#pragma unroll
        for (int ai = 0; ai < 2; ++ai)
#pragma unroll
            for (int m = 0; m < 4; ++m) { const int row = row0 + ai * 128 + m * 16;
                const float sc = __shfl(scl[ai], m * 16 + fr);
#pragma unroll
                for (int bj = 0; bj < 2; ++bj) {
                    f32x4 v0 = acc[ai][bj][m][0] * sc, v1 = acc[ai][bj][m][1] * sc;
                    const int c0 = colt + bj * 128 + wc * 32 + 8 * fq, head = c0 / 192, within = c0 - head * 192;
                    if (within >= 128) rope8(v0, v1, cs, row & (SEQ - 1), (within - 128) >> 1);
                    *(u32x4*)(O + (size_t)row * NQ + c0) = pack8(v0, v1);
                } }
    }
};
struct EpiKvUp {
    static constexpr bool PERM = true;
    bf16_t* O; const float* SS;
    __device__ __forceinline__ void operator()(AccRef acc, const pg8::Unit& u, int wr, int wc, int fr, int fq) const {
        const int row0 = u.pm * 256 + wr * 64 + fr, colt = u.pn * 256;
        float scl[2];
#pragma unroll
        for (int ai = 0; ai < 2; ++ai) { const float* sp = SS + (size_t)(u.pm * 256 + wr * 64 + ai * 128 + fq * 16 + fr) * 20 + 12;
            const f32x4 s0 = *(const f32x4*)(sp), s1 = *(const f32x4*)(sp + 4);
            const float ss = ((s0[0] + s0[1]) + (s0[2] + s0[3])) + ((s1[0] + s1[1]) + (s1[2] + s1[3]));
            scl[ai] = 1.0f / sqrtf(ss * (1.0f / KKV) + EPS); }
#pragma unroll
        for (int ai = 0; ai < 2; ++ai)
#pragma unroll
            for (int m = 0; m < 4; ++m) { const int row = row0 + ai * 128 + m * 16;
                const float sc = __shfl(scl[ai], m * 16 + fr);
#pragma unroll
                for (int bj = 0; bj < 2; ++bj) {
                    const f32x4 v0 = acc[ai][bj][m][0] * sc, v1 = acc[ai][bj][m][1] * sc;
                    *(u32x4*)(O + (size_t)row * NKV + colt + bj * 128 + wc * 32 + 8 * fq) = pack8(v0, v1);
                } }
    }
};
__device__ __forceinline__ void panel_step(unsigned* cnt, int pmAnn, int pmWait) {
    asm volatile("s_waitcnt vmcnt(0)" ::: "memory");
    __syncthreads();
    if (threadIdx.x == 0) {
        if (pmAnn >= 0) (void)__hip_atomic_fetch_add(cnt + pmAnn, 1u, __ATOMIC_RELAXED, __HIP_MEMORY_SCOPE_AGENT);
        if (pmWait >= 0) { unsigned spins = 0;
            while (__hip_atomic_load(cnt + pmWait, __ATOMIC_RELAXED, __HIP_MEMORY_SCOPE_AGENT) < 4u) { __builtin_amdgcn_s_sleep(2); if (++spins > (1u << 16)) break; }
            __builtin_amdgcn_fence(__ATOMIC_ACQUIRE, "agent"); asm volatile("s_waitcnt vmcnt(0)" ::: "memory"); }
    }
    __syncthreads();
}
template <int MODE> struct EpiResGate {
    static constexpr bool PERM = true;
    const float* basef; const bf16_t* baseb; bf16_t* tile; const float* gate; unsigned* cnt; LAS unsigned char* lds; bf16_t* XN; float* OUT; const float* gn; const float* MODp;
    int pmA, pnA, pmB, pnB;
    __device__ __forceinline__ void rows(int pm, int pn, int nrq) const {
        const int lane = threadIdx.x & 63, wv = threadIdx.x >> 6, m0 = pm * 256 + pn * 64 + wv * nrq;
        if (MODE == 0) { const float* mb = MODp + (size_t)(m0 >> 11) * 6144; modnorm_rows_b(tile, XN, gn, mb + 4096, mb + 3072, m0, lane, nrq); }
        else finalnorm_rows_b(tile, OUT, gn, m0, lane, nrq);
    }
    __device__ __forceinline__ void operator()(AccRef acc, const pg8::Unit& u, int wr, int wc, int fr, int fq) {
        const bool fast = (gridDim.x == 256);
        int nbm = -1, nbn = 0;
        if (fast) { if (pmA >= 0) { panel_step(cnt, pmA, pmB); nbm = pmB; nbn = pnB; } pmB = pmA; pnB = pnA; }
        const int row0 = u.pm * 256 + wr * 64 + fr, colt = u.pn * 256;
        const float* gb = gate + (size_t)((u.pm * 256) >> 11) * 6144;
        const __amdgpu_buffer_rsrc_t rs = __builtin_amdgcn_make_buffer_rsrc((void*)tile, 0, TOK * DM * 2, 0x00020000);
#pragma unroll
        for (int bj = 0; bj < 2; ++bj) {
            const int c0 = colt + bj * 128 + wc * 32 + 8 * fq;
            const f32x4 g0 = *(const f32x4*)(gb + c0), g1 = *(const f32x4*)(gb + c0 + 4);
#pragma unroll
            for (int ai = 0; ai < 2; ++ai)
#pragma unroll
                for (int m = 0; m < 4; ++m) { const int row = row0 + ai * 128 + m * 16; const size_t off = (size_t)row * DM + c0;
                    f32x4 b0, b1;
                    if (MODE == 0) { b0 = *(const f32x4*)(basef + off); b1 = *(const f32x4*)(basef + off + 4); }
                    else unpack8(*(const u32x4*)(baseb + off), b0, b1);
                    const f32x4 o0 = b0 + g0 * acc[ai][bj][m][0], o1 = b1 + g1 * acc[ai][bj][m][1];
                    __builtin_amdgcn_raw_buffer_store_b128(pack8(o0, o1), rs, (unsigned)(off * 2), 0, 16); }
        }
        pmA = u.pm; pnA = u.pn;
        if (fast) { if (nbm >= 0) rows(nbm, nbn, 8); }
        else { const bool last = panel_arrive_last(cnt, u.pm, 4u, lds); rows(u.pm, 0, last ? 32 : 0); }
    }
    __device__ __forceinline__ void finish() {
        if (gridDim.x != 256) return;
        panel_step(cnt, pmA, pmB); if (pmB >= 0) rows(pmB, pnB, 8);
        panel_step(cnt, -1, pmA); if (pmA >= 0) rows(pmA, pnA, 8);
    }
};
struct EpiSwiGLU {
    static constexpr bool PERM = true;
    bf16_t* O;
    __device__ __forceinline__ void operator()(AccRef acc, const pg8::Unit& u, int wr, int wc, int fr, int fq) const {
        const int row0 = u.pm * 256 + wr * 64 + fr, c0 = u.pn * 128 + wc * 32 + 8 * fq;
#pragma unroll
        for (int ai = 0; ai < 2; ++ai)
#pragma unroll
            for (int m = 0; m < 4; ++m) { const int row = row0 + ai * 128 + m * 16;
                f32x4 r[2];
#pragma unroll
                for (int n = 0; n < 2; ++n) { const f32x4 gt = acc[ai][0][m][n], up = acc[ai][1][m][n];
#pragma unroll
                    for (int e = 0; e < 4; ++e) { const float sg = __builtin_amdgcn_rcpf(1.0f + __builtin_amdgcn_exp2f(-gt[e] * LOG2E)); r[n][e] = gt[e] * sg * up[e]; } }
                *(u32x4*)(O + (size_t)row * NFF + c0) = pack8(r[0], r[1]);
            }
    }
};

struct Args {
    const float *x, *c, *w_ada, *b_ada, *g_mix, *w_in, *lq1, *lk1, *lq2, *lk2, *g_diff_out, *g_q_lat, *w_q_up, *g_kv_lat, *w_kv_up, *w_out, *g_ffn, *w_gate, *w_up, *w_down, *g_final;
    float* out; unsigned char* ws; int ph_lo, ph_hi;
};

__device__ __forceinline__ int src_col(int mode, int n) {
    if (mode == 0) { if (n < 2176) return n; if (n >= 2240) return -1; const int j = n - 2176; return 2176 + (j >> 1) + 32 * (j & 1); }
    if (mode == 1) { const int head = n / 192, w = n - head * 192; if (w < 128) return n; const int j = w - 128; return head * 192 + 128 + (j >> 1) + 32 * (j & 1); }
    if (mode == 3) { return (n >> 8) * 128 + (n & 127); }
    return n;
}
__device__ __forceinline__ void transpose_item(const float* W, const float* W2, int K, int Nsrc, bf16_t* WT, int mode, const float* gain, LAS float* scr, int item, int nblk, int lane) {
    const int kb = item / nblk, nb = item % nblk, k0 = 64 * kb, n0 = 32 * nb;
    const int nn = n0 + (lane & 31), sc = src_col(mode, nn);
    const float* Wp = (mode == 3 && ((nn >> 7) & 1)) ? W2 : W;
#pragma unroll 16
    for (int i = 0; i < 32; ++i) { const int kk = 2 * i + (lane >> 5); float v = (sc >= 0) ? Wp[(size_t)(k0 + kk) * Nsrc + sc] : 0.f; if (gain) v *= gain[k0 + kk]; scr[kk * 33 + (lane & 31)] = v; }
    asm volatile("s_waitcnt lgkmcnt(0)" ::: "memory");
    const int c = lane & 7;
#pragma unroll
    for (int j = 0; j < 4; ++j) { const int n = (lane >> 3) + 8 * j; const LAS float* s = scr + (8 * c) * 33 + n;
        u32x4 o; o.x = pk2(s[0 * 33], s[1 * 33]); o.y = pk2(s[2 * 33], s[3 * 33]); o.z = pk2(s[4 * 33], s[5 * 33]); o.w = pk2(s[6 * 33], s[7 * 33]);
        *(u32x4*)(WT + (size_t)(n0 + n) * K + k0 + 8 * c) = o; }
    asm volatile("s_waitcnt lgkmcnt(0)" ::: "memory");
}
__device__ __forceinline__ void adaln_item(const Args& a, float* MOD, LAS unsigned char* lds, int item) {
    LAS float* L = (LAS float*)lds;
    const int tid = threadIdx.x, lane = tid & 63, wid = tid >> 6, j0 = item * 64;
#pragma unroll 16
    for (int i = 0; i < 64; ++i) { const int idx = tid + 512 * i, b = idx >> 10, k = idx & 1023; const float v = a.c[idx]; L[k * 32 + (b ^ ((k & 7) << 2))] = v / (1.0f + __expf(-v)); }
    __syncthreads();
    float acc[32];
#pragma unroll
    for (int b = 0; b < 32; ++b) acc[b] = 0.f;
#pragma unroll 16
    for (int kk = 0; kk < 128; ++kk) { const int k = wid * 128 + kk; const float wv = a.w_ada[(size_t)k * 6144 + j0 + lane];
#pragma unroll
        for (int b4 = 0; b4 < 8; ++b4) { const f32x4 cv = *(const LAS f32x4*)(L + k * 32 + 4 * (b4 ^ (kk & 7)));
            acc[4 * b4 + 0] += wv * cv[0]; acc[4 * b4 + 1] += wv * cv[1]; acc[4 * b4 + 2] += wv * cv[2]; acc[4 * b4 + 3] += wv * cv[3]; } }
    __syncthreads();
#pragma unroll
    for (int b = 0; b < 32; ++b) L[(wid * 32 + b) * 64 + lane] = acc[b];
    __syncthreads();
#pragma unroll
    for (int i = 0; i < 4; ++i) { const int o = tid + 512 * i, b = o >> 6, col = o & 63; float s = a.b_ada[j0 + col];
#pragma unroll
        for (int w = 0; w < 8; ++w) s += L[(w * 32 + b) * 64 + col];
        MOD[(size_t)b * 6144 + j0 + col] = s; }
    __syncthreads();
}
__device__ __forceinline__ s16x4 vtr(const LAS unsigned char* p) { return __builtin_bit_cast(s16x4, __builtin_amdgcn_ds_read_tr16_b64_v4i16((LAS s16x4*)p)); }

template <bool DIFF>
__device__ __forceinline__ void attn_unit(LAS unsigned char* lds, const bf16_t* PROJ, const bf16_t* QBUF, const bf16_t* KVB, bf16_t* MRG, const float* gdo, float lam, int b, int h, int qb) {
    constexpr int DQK = DIFF ? 64 : 192, NDS = DQK / 16, QB = DIFF ? 128 : 256;
    constexpr int POFF = 16384, VOFF = DIFF ? 16384 : 24576, STAGE = VOFF + 16384;
    constexpr float THR = 8.0f;
    const int tid = threadIdx.x, lane = tid & 63, r32 = lane & 31, hi = lane >> 5, wid = __builtin_amdgcn_readfirstlane(tid >> 6);
    const int map = DIFF ? (wid >> 2) : 0, wq = DIFF ? (wid & 3) : wid;
    const int q0 = qb * QB, qw0 = q0 + 32 * wq, qpos = qw0 + r32;
    const size_t rowbase = (size_t)b * SEQ;
    const int NT = (q0 + QB) / 64, tw = qw0 >> 6;
    bf16x8 qf[NDS];
    { const bf16_t* qp = DIFF ? PROJ + (rowbase + qpos) * NPROJ + h * 128 + map * 64 : QBUF + (rowbase + qpos) * NQ + h * 192;
#pragma unroll
      for (int ds = 0; ds < NDS; ++ds) qf[ds] = *(const bf16x8*)(qp + ds * 16 + hi * 8); }
    u32x4 qaug = (u32x4){0u, 0u, 0u, 0u}, kaug0 = qaug, kaug1 = qaug;
    if (DIFF) {
        const float c1 = LOG2E / (float)(1 << (2 * (h + 1))), c64 = 64.f * c1;
        const unsigned c1h = f2bf(c1), c1l = f2bf(c1 - __uint_as_float(c1h << 16)), c6h = f2bf(c64), c6l = f2bf(c64 - __uint_as_float(c6h << 16));
        const unsigned j0 = __float_as_uint((float)r32) >> 16, j1 = __float_as_uint((float)(r32 + 32)) >> 16;
        if (hi == 0) { qaug.x = c1h | (c1l << 16); qaug.y = c6h | (c6l << 16); kaug0.x = j0 | (j0 << 16); kaug1.x = j1 | (j1 << 16); }
    }
    f32x16 o[4];
#pragma unroll
    for (int d0 = 0; d0 < 4; ++d0)
#pragma unroll
        for (int r = 0; r < 16; ++r) o[d0][r] = 0.f;
    f32x16 negm;
#pragma unroll
    for (int r = 0; r < 16; ++r) negm[r] = 0.f;
    float mrun = 0.f, lrun = 0.f;
    constexpr size_t PITCH = DIFF ? NPROJ : NKV;
    const int Lrr = (lane >> 2) & 7, Lsub = lane >> 5, Lslot = lane & 3;
    const int xr = (2 * ((wid >> 1) & 1) + (Lrr >> 2)) & 3, xp = (2 * (wid & 1) + (Lrr >> 2)) & 3;
    const int rowA = 8 * (wid >> 1) + Lrr, chA = 4 * (2 * (wid & 1) + Lsub) + (Lslot ^ xr);
    const bf16_t* gK = (DIFF ? PROJ + (rowbase + rowA) * NPROJ + 512 + h * 128 : KVB + (rowbase + rowA) * NKV + h * 256) + chA * 8;
    const bf16_t* gV = (DIFF ? PROJ + (rowbase + rowA) * NPROJ + 1024 + h * 128 : KVB + (rowbase + rowA) * NKV + h * 256 + 128) + chA * 8;
    const bf16_t* gP = PROJ + (rowbase + 8 * wid + Lrr) * NPROJ + 2176 + (4 * Lsub + (Lslot ^ xp)) * 8;
    const int dW = wid * 1024;
#define ATT_DMA(src, dst) __builtin_amdgcn_global_load_lds((const unsigned*)(src), (LAS unsigned*)(dst), 16, 0, 0)
#define ATT_LOAD(t, st) do { const size_t ro_ = (size_t)(t) * 64 * PITCH; LAS unsigned char* sb_ = lds + (st) * STAGE + dW; \
        ATT_DMA(gK + ro_, sb_); ATT_DMA(gK + ro_ + 32 * PITCH, sb_ + 8192); \
        ATT_DMA(gV + ro_, sb_ + VOFF); ATT_DMA(gV + ro_ + 32 * PITCH, sb_ + VOFF + 8192); \
        if (!DIFF) ATT_DMA(gP + (size_t)(t) * 64 * NPROJ, sb_ + POFF); } while (0)
#define ATT_BAR() do { asm volatile("" ::: "memory"); __builtin_amdgcn_s_barrier(); asm volatile("" ::: "memory"); } while (0)
#define SB() __builtin_amdgcn_sched_barrier(0)
    const int xq = (r32 >> 2) & 3;
    const int kb0 = 2048 * (r32 >> 3) + 64 * (r32 & 7) + 1024 * map + 16 * (hi ^ xq), kb1 = kb0 ^ 32;
    const int pb0 = POFF + 1024 * (r32 >> 3) + 64 * (r32 & 7) + 16 * (hi ^ xq), pb1 = pb0 ^ 32;
    const int vq = (lane & 15) >> 2, vp = lane & 3;
    const int vb0 = VOFF + 64 * (4 * hi + vq) + 16 * ((2 * ((lane >> 4) & 1)) | ((vp >> 1) ^ hi)) + 8 * (vp & 1), vb1 = vb0 ^ 32;
#define KFR(ds, hh) (*(const LAS bf16x8*)(sb + (((ds) & 1) ? kb1 : kb0) + 8192 * (hh) + 512 * ((ds) >> 1)))
#define PFR(dp, hh) (*(const LAS bf16x8*)(sb + (((dp) & 1) ? pb1 : pb0) + 4096 * (hh) + 512 * ((dp) >> 1)))
#define KMLA(ds, hh) ((ds) < 8 ? KFR(ds, hh) : PFR((ds) - 8, hh))
#define VTR(dst, addr, off) asm volatile("ds_read_b64_tr_b16 %0, %1 offset:%2" : "=v"(dst) : "v"(addr), "i"(off) : "memory")
    asm volatile("s_waitcnt lgkmcnt(0)" ::: "memory");
    ATT_BAR();
    ATT_LOAD(NT - 1, 0);
    if (NT > 1) ATT_LOAD(NT - 2, 1);
    bool first = true;
    int st = 0, st2 = 2;
    for (int it = 0; it < NT; ++it) {
        const int t = NT - 1 - it;
        if (it + 1 < NT) { if (DIFF) asm volatile("s_waitcnt vmcnt(4)" ::: "memory"); else asm volatile("s_waitcnt vmcnt(5)" ::: "memory"); }
        else asm volatile("s_waitcnt vmcnt(0)" ::: "memory");
        ATT_BAR();
        if (it + 2 < NT) ATT_LOAD(t - 2, st2);
        if (t <= tw) {
            const LAS unsigned char* sb = lds + st * STAGE;
            f32x16 s0, s1;
            if (DIFF) {
                bf16x8 kf[8];
#pragma unroll
                for (int i = 0; i < 4; ++i) { kf[2 * i] = KFR(i, 0); kf[2 * i + 1] = KFR(i, 1); }
                SB();
                const unsigned tb = __float_as_uint((float)t) >> 16;
                if (hi == 0) { kaug0.y = tb | (tb << 16); kaug1.y = kaug0.y; }
                __builtin_amdgcn_s_setprio(1);
                s0 = __builtin_amdgcn_mfma_f32_32x32x16_bf16(__builtin_bit_cast(bf16x8, kaug0), __builtin_bit_cast(bf16x8, qaug), negm, 0, 0, 0);
                s1 = __builtin_amdgcn_mfma_f32_32x32x16_bf16(__builtin_bit_cast(bf16x8, kaug1), __builtin_bit_cast(bf16x8, qaug), negm, 0, 0, 0);
#pragma unroll
                for (int ds = 0; ds < 4; ++ds) {
                    s0 = __builtin_amdgcn_mfma_f32_32x32x16_bf16(kf[2 * ds], qf[ds], s0, 0, 0, 0);
                    s1 = __builtin_amdgcn_mfma_f32_32x32x16_bf16(kf[2 * ds + 1], qf[ds], s1, 0, 0, 0);
                }
                __builtin_amdgcn_s_setprio(0);
            } else {
                bf16x8 kf[4];
#pragma unroll
                for (int i = 0; i < 2; ++i) { kf[2 * i] = KFR(i, 0); kf[2 * i + 1] = KFR(i, 1); }
#pragma unroll
                for (int g = 0; g < 6; ++g) {
                    bf16x8 kn[4];
                    if (g < 5) {
#pragma unroll
                        for (int i = 0; i < 2; ++i) { kn[2 * i] = KMLA(2 * g + 2 + i, 0); kn[2 * i + 1] = KMLA(2 * g + 2 + i, 1); }
                    }
                    SB();
                    __builtin_amdgcn_s_setprio(1);
                    if (g == 0) { s0 = __builtin_amdgcn_mfma_f32_32x32x16_bf16(kf[0], qf[0], negm, 0, 0, 0); s1 = __builtin_amdgcn_mfma_f32_32x32x16_bf16(kf[1], qf[0], negm, 0, 0, 0); }
                    else { s0 = __builtin_amdgcn_mfma_f32_32x32x16_bf16(kf[0], qf[2 * g], s0, 0, 0, 0); s1 = __builtin_amdgcn_mfma_f32_32x32x16_bf16(kf[1], qf[2 * g], s1, 0, 0, 0); }
                    s0 = __builtin_amdgcn_mfma_f32_32x32x16_bf16(kf[2], qf[2 * g + 1], s0, 0, 0, 0); s1 = __builtin_amdgcn_mfma_f32_32x32x16_bf16(kf[3], qf[2 * g + 1], s1, 0, 0, 0);
                    __builtin_amdgcn_s_setprio(0);
                    SB();
                    if (g < 5) {
#pragma unroll
                        for (int i = 0; i < 4; ++i) kf[i] = kn[i];
                    }
                }
            }
            s16x4 vl[4][4], vh[4][4];
            const unsigned va0 = (unsigned)(uintptr_t)(sb + vb0), va1 = (unsigned)(uintptr_t)(sb + vb1);
#pragma unroll
            for (int s = 0; s < 2; ++s)
#pragma unroll
                for (int d0 = 0; d0 < 4; ++d0) { VTR(vl[s][d0], va0, s * 4096 + d0 * 512); VTR(vh[s][d0], va1, s * 4096 + 2048 + d0 * 512); }
            SB();
            if (t == tw) {
                const int kvl = 64 * t + 4 * hi - qpos;
#pragma unroll
                for (int r = 0; r < 16; ++r) { const int cr = (r & 3) + 8 * (r >> 2); if (kvl + cr > 0) s0[r] = -1e30f; if (kvl + cr + 32 > 0) s1[r] = -1e30f; }
            }
            float mx = fmaxf(s0[0], s1[0]);
#pragma unroll
            for (int r = 1; r < 16; ++r) mx = fmaxf(fmaxf(mx, s0[r]), s1[r]);
            mx = fmaxf(mx, __shfl_xor(mx, 32));
            if (first || __any(mx > THR)) {
                const float dl = first ? mx : fmaxf(mx, 0.f);
                mrun += dl;
#pragma unroll
                for (int r = 0; r < 16; ++r) { s0[r] -= dl; s1[r] -= dl; negm[r] = -mrun; }
                asm volatile("" : "+v"(negm));
                if (!first) { const float f = __builtin_amdgcn_exp2f(-dl); lrun *= f;
#pragma unroll
                    for (int d0 = 0; d0 < 4; ++d0)
#pragma unroll
                        for (int r = 0; r < 16; ++r) o[d0][r] *= f; }
                first = false;
            }
            float ls = 0.f;
#pragma unroll
            for (int r = 0; r < 16; ++r) { s0[r] = __builtin_amdgcn_exp2f(s0[r]); s1[r] = __builtin_amdgcn_exp2f(s1[r]); ls += s0[r]; ls += s1[r]; }
            lrun += ls;
            u32x4 pw[4];
#pragma unroll
            for (int j = 0; j < 4; ++j) { pw[0][j] = cvt_pk_bf16(s0[2 * j], s0[2 * j + 1]); pw[1][j] = cvt_pk_bf16(s0[8 + 2 * j], s0[8 + 2 * j + 1]);
                                          pw[2][j] = cvt_pk_bf16(s1[2 * j], s1[2 * j + 1]); pw[3][j] = cvt_pk_bf16(s1[8 + 2 * j], s1[8 + 2 * j + 1]); }
            asm volatile("s_waitcnt lgkmcnt(0)" ::: "memory");
#pragma unroll
            for (int s = 2; s < 4; ++s)
#pragma unroll
                for (int d0 = 0; d0 < 4; ++d0) { VTR(vl[s][d0], va0, s * 4096 + d0 * 512); VTR(vh[s][d0], va1, s * 4096 + 2048 + d0 * 512); }
            SB();
#pragma unroll
            for (int s = 0; s < 4; ++s) {
                if (s == 2) { asm volatile("s_waitcnt lgkmcnt(0)" ::: "memory"); SB(); }
                __builtin_amdgcn_s_setprio(1);
#pragma unroll
                for (int d0 = 0; d0 < 4; ++d0) {
                    const bf16x8 vf = __builtin_shufflevector(vl[s][d0], vh[s][d0], 0, 1, 2, 3, 4, 5, 6, 7);
                    o[d0] = __builtin_amdgcn_mfma_f32_32x32x16_bf16(vf, __builtin_bit_cast(bf16x8, pw[s]), o[d0], 0, 0, 0);
                }
                __builtin_amdgcn_s_setprio(0);
            }
            SB();
        }
        st = (st == 2) ? 0 : st + 1; st2 = (st2 == 2) ? 0 : st2 + 1;
    }
    asm volatile("s_waitcnt lgkmcnt(0)" ::: "memory");
    ATT_BAR();
#undef ATT_DMA
#undef ATT_LOAD
#undef SB
#undef KFR
#undef PFR
#undef KMLA
#undef VTR
    const float inv = 1.0f / (lrun + __shfl_xor(lrun, 32));
    if (DIFF) {
        LAS float* X = (LAS float*)lds + (size_t)(wq * 64) * 64 + lane;
        if (map == 1) {
#pragma unroll
            for (int d0 = 0; d0 < 4; ++d0)
#pragma unroll
                for (int r = 0; r < 16; ++r) X[(d0 * 16 + r) * 64] = o[d0][r] * inv;
        }
        asm volatile("s_waitcnt lgkmcnt(0)" ::: "memory");
        ATT_BAR();
        if (map == 0) {
            float ss = 0.f;
#pragma unroll
            for (int d0 = 0; d0 < 4; ++d0)
#pragma unroll
                for (int r = 0; r < 16; ++r) { const float v = o[d0][r] * inv - lam * X[(d0 * 16 + r) * 64]; o[d0][r] = v; ss += v * v; }
            ss += __shfl_xor(ss, 32);
            const float rs = (1.0f - LAMBDA_INIT) / sqrtf(ss * (1.0f / 128.f) + EPS);
            bf16_t* op = MRG + (rowbase + qpos) * DM + h * 128;
#pragma unroll
            for (int d0 = 0; d0 < 4; ++d0)
#pragma unroll
                for (int gp = 0; gp < 2; ++gp) {
                    u32x2 w[2];
#pragma unroll
                    for (int k = 0; k < 2; ++k) { const int g = 2 * gp + k, d = 32 * d0 + 8 * g + 4 * hi; const f32x4 gg = *(const f32x4*)(gdo + d);
                        w[k].x = cvt_pk_bf16(o[d0][4 * g] * rs * gg[0], o[d0][4 * g + 1] * rs * gg[1]); w[k].y = cvt_pk_bf16(o[d0][4 * g + 2] * rs * gg[2], o[d0][4 * g + 3] * rs * gg[3]); }
                    const u32x2 snd = hi ? w[0] : w[1]; u32x2 rcv; rcv.x = __shfl_xor(snd.x, 32); rcv.y = __shfl_xor(snd.y, 32);
                    const u32x4 c = hi ? (u32x4){rcv.x, rcv.y, w[1].x, w[1].y} : (u32x4){w[0].x, w[0].y, rcv.x, rcv.y};
                    *(u32x4*)(op + 32 * d0 + 8 * (2 * gp + hi)) = c; }
        }
    } else {
        bf16_t* op = MRG + (rowbase + qpos) * DM + 512 + h * 128;
#pragma unroll
        for (int d0 = 0; d0 < 4; ++d0)
#pragma unroll
            for (int gp = 0; gp < 2; ++gp) {
                u32x2 w[2];
#pragma unroll
                for (int k = 0; k < 2; ++k) { const int g = 2 * gp + k;
                    w[k].x = cvt_pk_bf16(o[d0][4 * g] * inv, o[d0][4 * g + 1] * inv); w[k].y = cvt_pk_bf16(o[d0][4 * g + 2] * inv, o[d0][4 * g + 3] * inv); }
                const u32x2 snd = hi ? w[0] : w[1]; u32x2 rcv; rcv.x = __shfl_xor(snd.x, 32); rcv.y = __shfl_xor(snd.y, 32);
                const u32x4 c = hi ? (u32x4){rcv.x, rcv.y, w[1].x, w[1].y} : (u32x4){w[0].x, w[0].y, rcv.x, rcv.y};
                *(u32x4*)(op + 32 * d0 + 8 * (2 * gp + hi)) = c; }
    }
#undef ATT_BAR
}

#define XB_TMO      128
#define XB_XCNT(j)  (256  + 64 * (j))
#define XB_XSUB(j)  (1280 + 64 * (j))
#define XB_XGEN(j)  (2304 + 64 * (j))
#define XB_TOP      3328
#define XB_TOPGEN   3392
#define XCD_BAR_WORDS 3456
#define XB_SPIN_CAP (1u << 18)

__device__ __forceinline__ unsigned xb_ld(unsigned* p)              { return __hip_atomic_load(p, __ATOMIC_RELAXED, __HIP_MEMORY_SCOPE_AGENT); }
__device__ __forceinline__ unsigned xb_add(unsigned* p, unsigned v) { return __hip_atomic_fetch_add(p, v, __ATOMIC_RELAXED, __HIP_MEMORY_SCOPE_AGENT); }
__device__ __forceinline__ unsigned xb_xcc_id() { return (unsigned)__builtin_amdgcn_s_getreg((3 << 11) | 20) & 0xFu; }
#define XB_SPIN(cond, bar) do { unsigned _sp = 0; while (cond) { __builtin_amdgcn_s_sleep(1); \
    if ((++_sp & 255u) == 0u) { if (xb_ld(&(bar)[XB_TMO])) break; if (_sp > XB_SPIN_CAP) { atomicAdd(&(bar)[XB_TMO], 1u); break; } } } } while (0)

struct XcdBarrier {
    unsigned* bar; unsigned x;
    volatile LAS unsigned* st;
};

__device__ __forceinline__ XcdBarrier xcd_barrier_post(unsigned* bar, volatile LAS unsigned* st) {
    XcdBarrier b; b.bar = bar; b.x = xb_xcc_id(); b.st = st;
    if (threadIdx.x == 0) (void)xb_add(&bar[XB_XCNT(b.x)], 1u);
    return b;
}
__device__ __forceinline__ void xcd_barrier_complete(unsigned* bar, unsigned x, unsigned& nloc, unsigned& nx) {
    const unsigned G = gridDim.x * gridDim.y * gridDim.z;
    unsigned sum, cnt, mine, sp = 0u;
    for (;;) {
        sum = 0u; cnt = 0u; mine = 0u;
#pragma unroll
        for (unsigned j = 0; j < 16; ++j) { const unsigned c = xb_ld(&bar[XB_XCNT(j)]); sum += c; cnt += (c > 0u) ? 1u : 0u; mine = (j == x) ? c : mine; }
        if (sum == G) break;
        __builtin_amdgcn_s_sleep(1);
        if ((++sp & 255u) == 0u) { if (xb_ld(&bar[XB_TMO])) break; if (sp > XB_SPIN_CAP) { atomicAdd(&bar[XB_TMO], 1u); break; } }
    }
    nloc = mine > 0u ? mine : 1u; nx = cnt > 0u ? cnt : 1u;
}

__device__ __forceinline__ void xcd_barrier(const XcdBarrier& b) {
    asm volatile("s_waitcnt vmcnt(0)" ::: "memory");
    __syncthreads();
    if (threadIdx.x == 0) {
        unsigned* bar = b.bar;
        __builtin_amdgcn_s_waitcnt(0);
        unsigned nloc = b.st[0], nx = b.st[1];
        if (nloc == 0u) { xcd_barrier_complete(bar, b.x, nloc, nx); b.st[0] = nloc; b.st[1] = nx; }
        const unsigned old = xb_add(&bar[XB_XSUB(b.x)], 1u);
        const unsigned gen = old / nloc;
        if (old + 1u == (gen + 1u) * nloc) {
            __builtin_amdgcn_fence(__ATOMIC_RELEASE, "agent");
            asm volatile("s_waitcnt vmcnt(0)" ::: "memory");
            const unsigned og = xb_add(&bar[XB_TOP], 1u);
            const unsigned tg = og / nx;
            if (og + 1u == (tg + 1u) * nx) xb_add(&bar[XB_TOPGEN], 1u);
            else XB_SPIN(xb_ld(&bar[XB_TOPGEN]) == tg, bar);
            __builtin_amdgcn_fence(__ATOMIC_ACQUIRE, "agent");
            xb_add(&bar[XB_XGEN(b.x)], 1u);
            asm volatile("s_waitcnt vmcnt(0)" ::: "memory");
        } else {
            XB_SPIN(xb_ld(&bar[XB_XGEN(b.x)]) == gen, bar);
            __builtin_amdgcn_fence(__ATOMIC_ACQUIRE, "agent");
            asm volatile("s_waitcnt vmcnt(0)" ::: "memory");
        }
    }
    __syncthreads();
}


__global__ void __launch_bounds__(512, 2) fwd_kernel(Args a) {
    extern __shared__ __attribute__((aligned(16))) unsigned char lds_raw[];
    LAS unsigned char* lds = (LAS unsigned char*)lds_raw;
    cg::grid_group grid = cg::this_grid();
    const int tid = threadIdx.x, lane = tid & 63, wave = __builtin_amdgcn_readfirstlane(tid >> 6);
    const int G = gridDim.x, bx = blockIdx.x, vcu = (G % 8 == 0) ? (bx % 8) * (G / 8) + bx / 8 : bx;
    unsigned char* ws = a.ws;
    bf16_t *WIN = (bf16_t*)(ws + WS_WIN), *WQ = (bf16_t*)(ws + WS_WQ), *WKV = (bf16_t*)(ws + WS_WKV), *WOUT = (bf16_t*)(ws + WS_WOUT), *WGU = (bf16_t*)(ws + WS_WGU), *WDN = (bf16_t*)(ws + WS_WDN);
    float *MOD = (float*)(ws + WS_MOD), *CS = (float*)(ws + WS_CS), *SS = (float*)(ws + WS_SS); unsigned* CNT = (unsigned*)(ws + WS_SS2);
    bf16_t *XN = (bf16_t*)(ws + WS_XN), *PROJ = (bf16_t*)(ws + WS_PROJ), *QBUF = (bf16_t*)(ws + WS_Q), *KVB = (bf16_t*)(ws + WS_KV), *MRG = (bf16_t*)(ws + WS_MRG), *ACT = (bf16_t*)(ws + WS_ACT);
    bf16_t *X1B = KVB, *X2B = XN;
    const int lo = a.ph_lo, hi = a.ph_hi;
#ifndef PH_MASK
#define PH_MASK 0x3ff
#endif
#define IN(k) (((PH_MASK >> (k)) & 1) && lo <= (k) && (k) < hi)
    volatile LAS unsigned* xst = (volatile LAS unsigned*)(lds + RING_BYTES + 128);
    if (tid == 0) { xst[0] = 0u; xst[1] = 0u; }
    XcdBarrier xbar; xbar.bar = (unsigned*)ws; xbar.x = 0; xbar.st = xst;
#define SEAM(k) do { if (IN((k) + 1)) { if ((k) == 0) { grid.sync(); xbar = xcd_barrier_post((unsigned*)ws, xst); } else xcd_barrier(xbar); } } while (0)

    if (IN(0)) {
        if (bx == G - 1) { CNT[tid] = 0u; for (int i = tid; i < XCD_BAR_WORDS; i += 512) ((unsigned*)ws)[i] = 0u; }
        for (int it = bx; it < 96; it += G) adaln_item(a, MOD, lds, it);
        LAS float* scr = (LAS float*)(lds + wave * 16384);
        const int tfirst = (G > 128) ? 96 : 0;
        const int gw = (bx - tfirst) * 8 + wave, NGW = (G - tfirst) * 8;
        constexpr int I_IN = 16 * 72, I_Q = 6 * 24, I_KV = 4 * 32, I_O = 16 * 32, I_GU = 16 * 176, I_DN = 44 * 32;
        constexpr int NITEMS = I_IN + I_Q + I_KV + I_O + I_GU + I_DN;
        for (int it = (bx >= tfirst) ? gw : NITEMS; it < NITEMS; it += NGW) {
            int r = it;
            if (r < I_IN) { transpose_item(a.w_in, nullptr, 1024, 2240, WIN, 0, nullptr, scr, r, 72, lane); continue; } r -= I_IN;
            if (r < I_Q) { transpose_item(a.w_q_up, nullptr, KQ, NQ, WQ, 1, a.g_q_lat, scr, r, 24, lane); continue; } r -= I_Q;
            if (r < I_KV) { transpose_item(a.w_kv_up, nullptr, KKV, NKV, WKV, 2, a.g_kv_lat, scr, r, 32, lane); continue; } r -= I_KV;
            if (r < I_O) { transpose_item(a.w_out, nullptr, 1024, 1024, WOUT, 2, nullptr, scr, r, 32, lane); continue; } r -= I_O;
            if (r < I_GU) { transpose_item(a.w_gate, a.w_up, 1024, NFF, WGU, 3, nullptr, scr, r, 176, lane); continue; } r -= I_GU;
            transpose_item(a.w_down, nullptr, NFF, 1024, WDN, 2, nullptr, scr, r, 32, lane);
        }
        for (int e = bx * 512 + tid; e < SEQ * 32; e += G * 512) {
            const int t = e >> 5, i = e & 31;
            const float invf = __builtin_amdgcn_exp2f(-(float)i * (13.287712379549449f / 32.0f));
            const float ang = (float)t * invf;
            const double ad = (double)ang, kk = __builtin_rint(ad * 0.15915494309189535);
            const float rr = (float)(ad - kk * 6.283185307179586);
            CS[2 * e] = __cosf(rr); CS[2 * e + 1] = __sinf(rr);
        }
        SEAM(0);
    }
    if (IN(1)) {
        const int gw = vcu * 8 + wave, NGW = G * 8;
        for (int m = gw * 32; m < TOK; m += NGW * 32) { const float* mb = MOD + (size_t)(m >> 11) * 6144; modnorm_rows32(a.x, XN, a.g_mix, mb + 1024, mb, m, lane); }
        SEAM(1);
    }
    if (IN(2)) {
        pg8::Gemm g{XN, WIN, TOK, NPROJ, 1024, 1024}; pg8::StaticOrder S; S.init(TOK, NPROJ, G, bx);
        EpiInProj E{PROJ, SS, CS};
        pg8::gemm_phase<EpiInProj, true>(lds, g, S, E);
        SEAM(2);
    }
    if (IN(3)) {
        { pg8::Gemm g{PROJ + 1536, WQ, TOK, NQ, KQ, NPROJ}; pg8::StaticOrder S; S.init(TOK, NQ, G, bx); EpiQUp E{QBUF, SS, CS}; pg8::gemm_phase<EpiQUp, true>(lds, g, S, E); }
        { pg8::Gemm g{PROJ + 1920, WKV, TOK, NKV, KKV, NPROJ}; pg8::StaticOrder S; S.init(TOK, NKV, G, bx); EpiKvUp E{KVB, SS}; pg8::gemm_phase<EpiKvUp, true>(lds, g, S, E); }
        SEAM(3);
    }
    if (IN(4)) {
        float d1 = a.lq1[lane] * a.lk1[lane], d2 = a.lq2[lane] * a.lk2[lane];
        const float lam = __expf(wave_sum(d1)) - __expf(wave_sum(d2)) + LAMBDA_INIT;
        for (int pp = vcu, it_ = 0; pp < 1024; pp += G, ++it_)
            { { const int bh = (G == 256) ? 16 * (vcu >> 5) + 4 * it_ + ((vcu >> 3) & 3) : pp >> 3, pr = pp & 7;
                attn_unit<true>(lds, PROJ, QBUF, KVB, MRG, a.g_diff_out, lam, bh >> 2, bh & 3, 15 - pr);
                attn_unit<true>(lds, PROJ, QBUF, KVB, MRG, a.g_diff_out, lam, bh >> 2, bh & 3, pr); } }
        for (int pp = vcu, it_ = 0; pp < 512; pp += G, ++it_)
            { { const int bh = (G == 256) ? 16 * (vcu >> 5) + 8 * it_ + ((vcu >> 2) & 7) : pp >> 2, pr = pp & 3;
                attn_unit<false>(lds, PROJ, QBUF, KVB, MRG, a.g_diff_out, lam, bh >> 2, bh & 3, 7 - pr);
                attn_unit<false>(lds, PROJ, QBUF, KVB, MRG, a.g_diff_out, lam, bh >> 2, bh & 3, pr); } }
        __syncthreads();
        SEAM(4);
    }
    if (IN(5)) {
        pg8::Gemm g{MRG, WOUT, TOK, 1024, 1024, 1024}; pg8::StaticOrder S; S.init(TOK, 1024, G, bx);
        EpiResGate<0> E{a.x, nullptr, X1B, MOD + 2048, CNT, lds, XN, nullptr, a.g_ffn, MOD, -1, 0, -1, 0};
        pg8::gemm_phase<EpiResGate<0>, true>(lds, g, S, E);
        E.finish();
        if (IN(7)) xcd_barrier(xbar);
    }
    if (IN(7)) {
        pg8::Gemm g{XN, WGU, TOK, NGU, 1024, 1024}; pg8::StaticOrder S; S.init(TOK, NGU, G, bx);
        EpiSwiGLU E{ACT};
        pg8::gemm_phase<EpiSwiGLU, true>(lds, g, S, E);
        SEAM(7);
    }
    if (IN(8)) {
        pg8::Gemm g{ACT, WDN, TOK, 1024, NFF, NFF}; pg8::StaticOrder S; S.init(TOK, 1024, G, bx);
        EpiResGate<1> E{nullptr, X1B, X2B, MOD + 5120, CNT + 256, lds, nullptr, a.out, a.g_final, MOD, -1, 0, -1, 0};
        pg8::gemm_phase<EpiResGate<1>, true>(lds, g, S, E);
        E.finish();
    }
#undef IN
#undef SEAM
}

extern "C" void kernel_launch(void* const* d_in, const int* in_sizes, int n_in, void* d_out, int out_size, void* d_ws, size_t ws_size, hipStream_t stream) {
    static int grid = 0;
    if (grid == 0) {
        if (n_in != 21 || in_sizes[0] != TOK * DM || out_size != TOK * DM || ws_size < WS_END) { fprintf(stderr, "kernel_launch: unexpected shapes (n_in %d, ws %zu)\n", n_in, ws_size); grid = -1; return; }
        int dev = 0, cus = 0, per_cu = 0;
        if (hipGetDevice(&dev) != hipSuccess || hipDeviceGetAttribute(&cus, hipDeviceAttributeMultiprocessorCount, dev) != hipSuccess) { grid = -1; return; }
        if (hipFuncSetAttribute((const void*)fwd_kernel, hipFuncAttributeMaxDynamicSharedMemorySize, LDS_BYTES) != hipSuccess) { fprintf(stderr, "kernel_launch: hipFuncSetAttribute failed\n"); grid = -1; return; }
        if (hipOccupancyMaxActiveBlocksPerMultiprocessor(&per_cu, (const void*)fwd_kernel, 512, LDS_BYTES) != hipSuccess || per_cu < 1) { fprintf(stderr, "kernel_launch: occupancy query gave %d\n", per_cu); per_cu = 1; }
        (void)hipGetLastError();
        grid = cus * (per_cu > 1 ? 1 : per_cu);
    }
    if (grid < 0) return;
    Args a{};
    const float** fp = (const float**)&a;
    for (int i = 0; i < 21; ++i) fp[i] = (const float*)d_in[i];
    a.out = (float*)d_out; a.ws = (unsigned char*)d_ws;
#if MK_NL == 1
    a.ph_lo = 0; a.ph_hi = 10;
    void* args[] = {&a};
    hipError_t e = hipLaunchCooperativeKernel((const void*)fwd_kernel, dim3(grid), dim3(512), args, LDS_BYTES, stream);
    if (e != hipSuccess) fprintf(stderr, "cooperative launch failed: %s (grid %d)\n", hipGetErrorString(e), grid);
#else
#ifndef PROBE_SEQ
#define PROBE_SEQ 0, 1, 2, 3, 4, 5, 7, 8
#endif
    static const int seq[] = {PROBE_SEQ};
    for (unsigned i = 0; i < sizeof(seq) / sizeof(seq[0]); ++i) { const int k = seq[i]; a.ph_lo = k; a.ph_hi = k + 1; hipLaunchKernelGGL(fwd_kernel, dim3(grid), dim3(512), LDS_BYTES, stream, a); }
#endif
}
```
